# Optimizing an MI355X kernel written in HIP

```python
import jax, jax.numpy as jnp
from jax import lax
import numpy as np

D_MODEL = 1024
BATCH = 16
SEQ = 4096
DEPTH = 1
DEC_BATCH = 4
DEC_SEQ = 8192
PAST_LEN = 128

N_MEM = 256
MIX_WIDTH = D_MODEL
RET_WIDTH = MIX_WIDTH // 2
RET_HEADS = 4
RET_HEAD_DIM = RET_WIDTH // RET_HEADS
RET_CHUNK = 128
SGU_WIDTH = MIX_WIDTH - RET_WIDTH
SGU_GROUPS = 4
SGU_GROUP_DIM = SGU_WIDTH // SGU_GROUPS
SGU_CHUNK = 128
XA_HEADS = 4
XA_HEAD_DIM = D_MODEL // XA_HEADS
D_FF = ((-(-8 * D_MODEL // 3)) + 255) // 256 * 256
W_IN_COLS = 4 * RET_WIDTH + 2 * SGU_WIDTH
ROPE_BASE = 10000.0
EPS = 1e-6
N_NORMS = 7
NORM_PRE_MIX, NORM_POST_MIX, NORM_PRE_XA, NORM_POST_XA, NORM_MEM, NORM_PRE_FFN, NORM_POST_FFN = range(N_NORMS)

kernel_name = "hybrid_retention_sgu_encoder"


def rms_norm(x, w):
    xf = x.astype(jnp.float32)
    y = xf * lax.rsqrt(jnp.mean(xf * xf, axis=-1, keepdims=True) + EPS)
    return (y * w.astype(jnp.float32)).astype(x.dtype)


def layer_norm_nobias(x, w):
    xf = x.astype(jnp.float32)
    mu = jnp.mean(xf, axis=-1, keepdims=True)
    var = jnp.mean(jnp.square(xf - mu), axis=-1, keepdims=True)
    return ((xf - mu) * lax.rsqrt(var + EPS) * w.astype(jnp.float32)).astype(x.dtype)


def rotary(x):
    s, dh = x.shape[1], x.shape[3]
    half = dh // 2
    inv = ROPE_BASE ** (-jnp.arange(half, dtype=jnp.float32) / half)
    ang = jnp.arange(s, dtype=jnp.float32)[:, None] * inv[None, :]
    cos = jnp.cos(ang)[None, :, None, :]
    sin = jnp.sin(ang)[None, :, None, :]
    xf = x.astype(jnp.float32)
    x1, x2 = xf[..., :half], xf[..., half:]
    return jnp.concatenate([x1 * cos - x2 * sin, x1 * sin + x2 * cos], axis=-1)


def decay_scan(contrib, decay_chunk, reverse):
    def step(state, c):
        return decay_chunk[None, :, None, None] * state + c, state
    _, states = lax.scan(step, jnp.zeros_like(contrib[0]), contrib, reverse=reverse)
    return states


def bidir_retention(q, k, v, log_gamma):
    b, s, h, d = q.shape
    c = RET_CHUNK
    nc = s // c
    lg = log_gamma.astype(jnp.float32)
    lf, lb = lg[0], lg[1]
    idx = jnp.arange(c, dtype=jnp.float32)
    qc = q.reshape(b, nc, c, h, d)
    kc = k.reshape(b, nc, c, h, d)
    vc = v.reshape(b, nc, c, h, d)
    dist = idx[:, None] - idx[None, :]
    adist = jnp.abs(dist)
    d_intra = jnp.where(dist[None] >= 0, jnp.exp(lf[:, None, None] * adist[None]),
                        jnp.exp(lb[:, None, None] * adist[None]))
    scores = jnp.einsum('bcihd,bcjhd->bchij', qc, kc) * d_intra[None, None]
    y = jnp.einsum('bchij,bcjhe->bcihe', scores, vc)
    kf = kc * jnp.exp(lf[None, :] * (c - 1 - idx)[:, None])[None, None, :, :, None]
    w_f = jnp.einsum('bcjhd,bcjhe->cbhde', kf, vc)
    r_f = decay_scan(w_f, jnp.exp(lf * c), reverse=False)
    qf = qc * jnp.exp(lf[None, :] * (idx + 1.0)[:, None])[None, None, :, :, None]
    y = y + jnp.einsum('bcihd,cbhde->bcihe', qf, r_f)
    kb = kc * jnp.exp(lb[None, :] * idx[:, None])[None, None, :, :, None]
    w_b = jnp.einsum('bcjhd,bcjhe->cbhde', kb, vc)
    r_b = decay_scan(w_b, jnp.exp(lb * c), reverse=True)
    qb = qc * jnp.exp(lb[None, :] * (c - idx)[:, None])[None, None, :, :, None]
    y = y + jnp.einsum('bcihd,cbhde->bcihe', qb, r_b)
    return y.reshape(b, s, h, d)


def token_mixer(h, w_in, ret_log_gamma, ret_gn_w, sgu_norm_w, sgu_w, sgu_b, w_out):
    b, s, _ = h.shape
    z = h @ w_in
    q, k, v, g, u, vs = jnp.split(z, [RET_WIDTH, 2 * RET_WIDTH, 3 * RET_WIDTH, 4 * RET_WIDTH,
                                      4 * RET_WIDTH + SGU_WIDTH], axis=-1)
    q = rotary(q.reshape(b, s, RET_HEADS, RET_HEAD_DIM))
    k = rotary(k.reshape(b, s, RET_HEADS, RET_HEAD_DIM)) * (RET_HEAD_DIM ** -0.5)
    vh = v.reshape(b, s, RET_HEADS, RET_HEAD_DIM).astype(jnp.float32)
    y = bidir_retention(q, k, vh, ret_log_gamma)
    mu = jnp.mean(y, axis=-1, keepdims=True)
    var = jnp.mean(jnp.square(y - mu), axis=-1, keepdims=True)
    y = ((y - mu) * lax.rsqrt(var + EPS)).reshape(b, s, RET_WIDTH) * ret_gn_w.astype(jnp.float32)
    ret_out = (jax.nn.silu(g.astype(jnp.float32)) * y).astype(h.dtype)
    u = jax.nn.gelu(u)
    vs = layer_norm_nobias(jax.nn.gelu(vs), sgu_norm_w)
    nc = s // SGU_CHUNK
    vs = vs.reshape(b, nc, SGU_CHUNK, SGU_GROUPS, SGU_GROUP_DIM)
    sp = jnp.einsum('gpq,bcqgd->bcpgd', sgu_w, vs) + jnp.transpose(sgu_b)[None, None, :, :, None]
    sgu_out = u * sp.reshape(b, s, SGU_WIDTH)
    mixed = jnp.concatenate([ret_out, sgu_out.astype(h.dtype)], axis=-1)
    return mixed @ w_out


def memory_cross_attention(h, mem_n, wq, wkv, wo):
    b, s, _ = h.shape
    m = mem_n.shape[1]
    q = (h @ wq).reshape(b, s, XA_HEADS, XA_HEAD_DIM)
    kv = mem_n @ wkv
    k = kv[..., :D_MODEL].reshape(b, m, XA_HEADS, XA_HEAD_DIM)
    v = kv[..., D_MODEL:].reshape(b, m, XA_HEADS, XA_HEAD_DIM)
    sc = jnp.einsum('bshd,bmhd->bhsm', q, k).astype(jnp.float32) * (XA_HEAD_DIM ** -0.5)
    p = jax.nn.softmax(sc, axis=-1).astype(v.dtype)
    o = jnp.einsum('bhsm,bmhd->bshd', p, v).reshape(b, s, D_MODEL)
    return o @ wo


def swiglu(h, w_gu, w_down):
    gu = h @ w_gu
    gate, up = gu[..., :D_FF], gu[..., D_FF:]
    return (jax.nn.silu(gate) * up) @ w_down


def encoder_layer(x, mem, nw, w_in, ret_log_gamma, ret_gn_w, sgu_norm_w, sgu_w, sgu_b, w_out,
                  xa_wq, xa_wkv, xa_wo, ffn_w_gu, ffn_w_down):
    mix = token_mixer(rms_norm(x, nw[NORM_PRE_MIX]), w_in, ret_log_gamma, ret_gn_w,
                      sgu_norm_w, sgu_w, sgu_b, w_out)
    x = x + rms_norm(mix, nw[NORM_POST_MIX])
    mem_n = rms_norm(mem, nw[NORM_MEM])
    xa = memory_cross_attention(rms_norm(x, nw[NORM_PRE_XA]), mem_n, xa_wq, xa_wkv, xa_wo)
    x = x + rms_norm(xa, nw[NORM_POST_XA])
    ff = swiglu(rms_norm(x, nw[NORM_PRE_FFN]), ffn_w_gu, ffn_w_down)
    return x + rms_norm(ff, nw[NORM_POST_FFN])


def setup_inputs(seed: int = 0) -> dict:
    key = jax.random.key(seed)
    ks = jax.random.split(key, 20)
    nrm = jax.random.normal
    f32 = jnp.float32
    base_lg = jnp.log(1.0 - 2.0 ** (-5.0 - jnp.arange(RET_HEADS, dtype=f32)))
    return {
        "x_prompt": nrm(ks[0], (BATCH, SEQ, D_MODEL), f32),
        "x_sample": nrm(ks[1], (DEC_BATCH, DEC_SEQ, D_MODEL), f32),
        "mem_prompt": nrm(ks[2], (BATCH, N_MEM, D_MODEL), f32),
        "mem_sample": nrm(ks[3], (DEC_BATCH, N_MEM, D_MODEL), f32),
        "norm_w": 1.0 + 0.05 * nrm(ks[4], (DEPTH, N_NORMS, D_MODEL), f32),
        "w_in": nrm(ks[5], (DEPTH, D_MODEL, W_IN_COLS), f32) * D_MODEL ** -0.5,
        "ret_log_gamma": base_lg[None, None, :] * jnp.exp(0.1 * nrm(ks[6], (DEPTH, 2, RET_HEADS), f32)),
        "ret_gn_w": 1.0 + 0.05 * nrm(ks[7], (DEPTH, RET_WIDTH), f32),
        "sgu_norm_w": 1.0 + 0.05 * nrm(ks[8], (DEPTH, SGU_WIDTH), f32),
        "sgu_w": nrm(ks[9], (DEPTH, SGU_GROUPS, SGU_CHUNK, SGU_CHUNK), f32) * SGU_CHUNK ** -0.5,
        "sgu_b": 1.0 + 0.1 * nrm(ks[10], (DEPTH, SGU_GROUPS, SGU_CHUNK), f32),
        "w_out": nrm(ks[11], (DEPTH, MIX_WIDTH, D_MODEL), f32) * MIX_WIDTH ** -0.5,
        "xa_wq": nrm(ks[12], (DEPTH, D_MODEL, D_MODEL), f32) * D_MODEL ** -0.5,
        "xa_wkv": nrm(ks[13], (DEPTH, D_MODEL, 2 * D_MODEL), f32) * D_MODEL ** -0.5,
        "xa_wo": nrm(ks[14], (DEPTH, D_MODEL, D_MODEL), f32) * D_MODEL ** -0.5,
        "ffn_w_gu": nrm(ks[15], (DEPTH, D_MODEL, 2 * D_FF), f32) * D_MODEL ** -0.5,
        "ffn_w_down": nrm(ks[16], (DEPTH, D_FF, D_MODEL), f32) * D_FF ** -0.5,
    }


def reference(x_prompt, x_sample, mem_prompt, mem_sample, norm_w, w_in, ret_log_gamma, ret_gn_w,
              sgu_norm_w, sgu_w, sgu_b, w_out, xa_wq, xa_wkv, xa_wo, ffn_w_gu, ffn_w_down):
    y_prompt = x_prompt
    y_sample = x_sample
    for l in range(DEPTH):
        y_prompt = encoder_layer(y_prompt, mem_prompt, norm_w[l], w_in[l], ret_log_gamma[l], ret_gn_w[l],
                                 sgu_norm_w[l], sgu_w[l], sgu_b[l], w_out[l], xa_wq[l], xa_wkv[l], xa_wo[l],
                                 ffn_w_gu[l], ffn_w_down[l])
        y_sample = encoder_layer(y_sample, mem_sample, norm_w[l], w_in[l], ret_log_gamma[l], ret_gn_w[l],
                                 sgu_norm_w[l], sgu_w[l], sgu_b[l], w_out[l], xa_wq[l], xa_wkv[l], xa_wo[l],
                                 ffn_w_gu[l], ffn_w_down[l])
    return (y_prompt, y_sample)
```

```cpp
#include <hip/hip_runtime.h>
#include <hip/hip_cooperative_groups.h>
#include <cstdio>
#define PG8_V2 1
namespace pg8 {
#define PG8_LAS __attribute__((address_space(3)))
typedef unsigned short bf16_t;
typedef short bf16x8 __attribute__((ext_vector_type(8)));
typedef float f32x4 __attribute__((ext_vector_type(4)));
typedef unsigned u32x4 __attribute__((ext_vector_type(4)));
constexpr int BM = 256, BK = 64, HALF = 128, HTB = HALF * BK * 2  , STAGE_BYTES = 8 * HTB, NXCD = 8, WGM = 8;

__host__ __device__ __forceinline__ int lds_byte(int r, int c) { const int st = (r >> 4) * 2 + (c >> 5), rr = r & 15, cc = c & 31, ob = rr * 64 + cc * 2; return st * 1024 + (ob ^ (((ob >> 9) & 1) << 5)); }
__host__ __device__ __forceinline__ void stage_rc(int b, int& R, int& C) { const int st = b / 1024, sb = b % 1024, swz = sb ^ (((sb >> 9) & 1) << 5); R = (st >> 1) * 16 + swz / 64; C = (st & 1) * 32 + (swz % 64) / 2; }
__host__ __device__ __forceinline__ int perm32(int rho) { const int n = rho >> 4, i = rho & 15; return 8 * (i >> 2) + 4 * n + (i & 3); }

struct Unit { int pm, pn; };
struct Gemm { const bf16_t* A; const bf16_t* Bt; int M, N, K; };

struct StaticOrder {
    int nM, nN, nwg, G, c;
    __host__ __device__ void init(int M, int N, int G_, int c_) { nM = M / BM; nN = N / BM; nwg = nM * nN; G = G_; c = c_; }
    __host__ __device__ bool next(int i, Unit& u) const {
        const long L = (long)i * G + c; if (L >= nwg) return false;
        int wgid = (int)L; { const int q = nwg / NXCD, r = nwg % NXCD, xcd = wgid % NXCD, off = wgid / NXCD; wgid = (xcd < r ? xcd * (q + 1) : r * (q + 1) + (xcd - r) * q) + off; }
        const int nig = WGM * nN, gid = wgid / nig, fm = gid * WGM, gsz = (nM - fm) < WGM ? (nM - fm) : WGM;
        u.pm = fm + ((wgid % nig) % gsz); u.pn = (wgid % nig) / gsz; return true;
    }
    __device__ __forceinline__ void a_ready(const Unit&) const {}
    __device__ __forceinline__ void done(const Unit&) const {}
};
typedef float f32x2_cv __attribute__((ext_vector_type(2))); typedef __bf16 bf16x2_cv __attribute__((ext_vector_type(2)));
__device__ __forceinline__ unsigned cvt_pk_bf16(float lo, float hi) { const f32x2_cv v = {lo, hi}; return __builtin_bit_cast(unsigned, __builtin_convertvector(v, bf16x2_cv)); }
template <class Epi, class Sched, bool ALIGN_EPI = false, bool SP2 = false>
__device__ __forceinline__ void gemm_phase(PG8_LAS unsigned char* lds, const Gemm g, const Sched& S, const Epi& E) {
    int tid_l = threadIdx.x; asm volatile("" : "+v"(tid_l));
    const int tid = tid_l, wid = __builtin_amdgcn_readfirstlane(tid >> 6), lane = tid & 63, wr = wid >> 2, wc = wid & 3, fr = lane & 15, fq = lane >> 4;
    const int K = g.K, nt = K / BK;
    unsigned voffA[2], voffB[2];
#pragma unroll
    for (int i = 0; i < 2; ++i) { int R, C; stage_rc(tid * 16 + i * 8192, R, C); const int Rb = Epi::PERM ? ((R & ~31) + perm32(R & 31)) : R;
        voffA[i] = (unsigned)(R * K + C) * 2u; voffB[i] = (unsigned)(Rb * K + C) * 2u; }
    const size_t kstep = (size_t)(BK * 2);
    const size_t hstep = (size_t)HALF * K * 2;
    const size_t tstep = 2 * hstep;
    const unsigned ldsw = (unsigned)wid * 1024u;
    const int aoff = lds_byte(wr * 64 + fr, fq * 8), boff = lds_byte(wc * 32 + fr, fq * 8);
#define PG8_SA(b, h) (((b) * 2 + (h)) * HTB)
#define PG8_SB(b, h) ((4 + (b) * 2 + (h)) * HTB)
#define PG8_STAGE(bufoff, gbase, voff) do { _Pragma("unroll") for (int _i = 0; _i < 2; ++_i) \
        __builtin_amdgcn_global_load_lds((const unsigned*)((const char*)(gbase) + (voff)[_i]), (PG8_LAS unsigned*)(lds + (bufoff) + ldsw + _i * 8192), 16, 0, 0); } while (0)
#define PG8_LDA(dst, b, h) do { _Pragma("unroll") for (int m = 0; m < 4; ++m) _Pragma("unroll") for (int k = 0; k < 2; ++k) dst[m][k] = *(const PG8_LAS bf16x8*)(lds + PG8_SA(b, h) + aoff + m * 2048 + k * 1024); } while (0)
#define PG8_LDB(dst, b, h) do { _Pragma("unroll") for (int n = 0; n < 2; ++n) _Pragma("unroll") for (int k = 0; k < 2; ++k) dst[n][k] = *(const PG8_LAS bf16x8*)(lds + PG8_SB(b, h) + boff + n * 2048 + k * 1024); } while (0)
#define PG8_MMA(ai, bj, At, Bt) do { __builtin_amdgcn_s_setprio(1); _Pragma("unroll") for (int m = 0; m < 4; ++m) _Pragma("unroll") for (int n = 0; n < 2; ++n) _Pragma("unroll") for (int k = 0; k < 2; ++k) \
        acc[ai][bj][m][n] = __builtin_amdgcn_mfma_f32_16x16x32_bf16(Bt[n][k], At[m][k], acc[ai][bj][m][n], 0, 0, 0); __builtin_amdgcn_s_setprio(0); } while (0)
#define PG8_WAIT_V(n) asm volatile("s_waitcnt vmcnt(" #n ")" ::: "memory")
#define PG8_WAIT_L(n) asm volatile("s_waitcnt lgkmcnt(" #n ")" ::: "memory")
#define PG8_BAR __builtin_amdgcn_s_barrier()
#define PG8_SCHED __builtin_amdgcn_sched_barrier(0)
    Unit cur, nxt; int ui = 0;
    if (!S.next(0, cur)) return;
    f32x4 acc[2][2][4][2];
#pragma unroll
    for (int a = 0; a < 2; ++a)
#pragma unroll
        for (int b = 0; b < 2; ++b)
#pragma unroll
            for (int m = 0; m < 4; ++m)
#pragma unroll
                for (int n = 0; n < 2; ++n) acc[a][b][m][n] = (f32x4){0.f, 0.f, 0.f, 0.f};
    bf16x8 At[4][2], B0[2][2], B1[2][2];
    const char* cA = (const char*)g.A + (size_t)cur.pm * tstep; const char* cB = (const char*)g.Bt + (size_t)cur.pn * tstep;
    S.a_ready(cur);
    if constexpr (SP2) {
        PG8_STAGE(PG8_SB(0, 0), cB, voffB); PG8_STAGE(PG8_SB(0, 1), cB + hstep, voffB); PG8_STAGE(PG8_SA(0, 0), cA, voffA); PG8_STAGE(PG8_SA(0, 1), cA + hstep, voffA);
        if (wr == 1) PG8_BAR;
        PG8_WAIT_V(2); PG8_BAR;
        PG8_STAGE(PG8_SB(1, 0), cB + kstep, voffB); PG8_STAGE(PG8_SA(1, 0), cA + kstep, voffA); PG8_STAGE(PG8_SB(1, 1), cB + hstep + kstep, voffB);
        PG8_WAIT_V(6); PG8_BAR;
    } else {
        PG8_STAGE(PG8_SB(0, 0), cB, voffB); PG8_STAGE(PG8_SA(0, 0), cA, voffA); PG8_STAGE(PG8_SB(0, 1), cB + hstep, voffB); PG8_STAGE(PG8_SA(0, 1), cA + hstep, voffA);
        if (wr == 1) PG8_BAR;
        PG8_WAIT_V(4); PG8_BAR;
        PG8_STAGE(PG8_SB(1, 0), cB + kstep, voffB); PG8_STAGE(PG8_SA(1, 0), cA + kstep, voffA); PG8_STAGE(PG8_SB(1, 1), cB + hstep + kstep, voffB);
        PG8_WAIT_V(6); PG8_BAR;
    }
    for (;;) {
        const bool has_next = S.next(ui + 1, nxt);
        const char* nA = has_next ? (const char*)g.A + (size_t)nxt.pm * tstep : cA; const char* nB = has_next ? (const char*)g.Bt + (size_t)nxt.pn * tstep : cB;
        for (int t = 0; t < nt; t += 2) {
            const bool last = (t == nt - 2);
            const char* a1 = cA + (size_t)(t + 1) * kstep;
            const char* a2 = last ? nA : cA + (size_t)(t + 2) * kstep; const char* b2 = last ? nB : cB + (size_t)(t + 2) * kstep;
            const char* a3 = a2 + kstep; const char* b3 = b2 + kstep;
            if (last && has_next) S.a_ready(nxt);
            if constexpr (SP2) {
            PG8_LDB(B0, 0, 0); PG8_LDB(B1, 0, 1); PG8_SCHED; PG8_LDA(At, 0, 0); PG8_STAGE(PG8_SA(1, 1), a1 + hstep, voffA);
            PG8_WAIT_V(8); PG8_WAIT_L(0); PG8_BAR; PG8_MMA(0, 0, At, B0); PG8_MMA(0, 1, At, B1); PG8_BAR; PG8_SCHED;
            PG8_LDA(At, 0, 1); PG8_STAGE(PG8_SB(0, 0), b2, voffB); PG8_STAGE(PG8_SB(0, 1), b2 + hstep, voffB); PG8_STAGE(PG8_SA(0, 0), a2, voffA);
            PG8_WAIT_V(8); PG8_WAIT_L(0); PG8_BAR; PG8_MMA(1, 0, At, B0); PG8_MMA(1, 1, At, B1); PG8_BAR; PG8_SCHED;
            PG8_LDB(B0, 1, 0); PG8_LDB(B1, 1, 1); PG8_SCHED; PG8_LDA(At, 1, 0); PG8_STAGE(PG8_SA(0, 1), a2 + hstep, voffA);
            PG8_WAIT_V(8); PG8_WAIT_L(0); PG8_BAR; PG8_MMA(0, 0, At, B0); PG8_MMA(0, 1, At, B1); PG8_BAR; PG8_SCHED;
            PG8_LDA(At, 1, 1); PG8_STAGE(PG8_SB(1, 0), b3, voffB); PG8_STAGE(PG8_SB(1, 1), b3 + hstep, voffB); PG8_STAGE(PG8_SA(1, 0), a3, voffA);
            PG8_WAIT_V(8); PG8_WAIT_L(0); PG8_BAR; PG8_MMA(1, 0, At, B0); PG8_MMA(1, 1, At, B1); PG8_BAR; PG8_SCHED;
            } else {
            PG8_LDB(B0, 0, 0); PG8_SCHED; PG8_LDA(At, 0, 0); PG8_STAGE(PG8_SA(1, 1), a1 + hstep, voffA);
            PG8_WAIT_L(8); PG8_BAR; PG8_WAIT_L(0); PG8_MMA(0, 0, At, B0); PG8_BAR; PG8_SCHED;
            PG8_LDB(B1, 0, 1); PG8_STAGE(PG8_SB(0, 0), b2, voffB);
            PG8_BAR; PG8_WAIT_L(0); PG8_MMA(0, 1, At, B1); PG8_BAR;
            PG8_LDA(At, 0, 1); PG8_STAGE(PG8_SA(0, 0), a2, voffA);
            PG8_BAR; PG8_WAIT_L(0); PG8_MMA(1, 0, At, B0); PG8_BAR; PG8_SCHED;
            PG8_STAGE(PG8_SB(0, 1), b2 + hstep, voffB);
            PG8_WAIT_V(6); PG8_BAR; PG8_MMA(1, 1, At, B1); PG8_BAR;
            PG8_LDB(B0, 1, 0); PG8_SCHED; PG8_LDA(At, 1, 0); PG8_STAGE(PG8_SA(0, 1), a2 + hstep, voffA);
            PG8_WAIT_L(8); PG8_BAR; PG8_WAIT_L(0); PG8_MMA(0, 0, At, B0); PG8_BAR; PG8_SCHED;
            PG8_LDB(B1, 1, 1); PG8_STAGE(PG8_SB(1, 0), b3, voffB);
            PG8_BAR; PG8_WAIT_L(0); PG8_MMA(0, 1, At, B1); PG8_BAR;
            PG8_LDA(At, 1, 1); PG8_STAGE(PG8_SA(1, 0), a3, voffA);
            PG8_BAR; PG8_WAIT_L(0); PG8_MMA(1, 0, At, B0); PG8_BAR; PG8_SCHED;
            PG8_STAGE(PG8_SB(1, 1), b3 + hstep, voffB);
            PG8_WAIT_V(6); PG8_BAR; PG8_MMA(1, 1, At, B1); PG8_BAR;
            }
        }
        if constexpr (ALIGN_EPI) { if (wr == 0) PG8_BAR; }
        if constexpr (!Epi::AFTER_DRAIN) { E(acc, cur, wr, wc, fr, fq); S.done(cur); }
        if (!has_next) break;
#pragma unroll
        for (int a = 0; a < 2; ++a)
#pragma unroll
            for (int b = 0; b < 2; ++b)
#pragma unroll
                for (int m = 0; m < 4; ++m)
#pragma unroll
                    for (int n = 0; n < 2; ++n) acc[a][b][m][n] = (f32x4){0.f, 0.f, 0.f, 0.f};
        cur = nxt; cA = nA; cB = nB; ++ui;
        if constexpr (ALIGN_EPI) { if (wr == 1) PG8_BAR; }
    }
    PG8_WAIT_V(0);
    if constexpr (!ALIGN_EPI) { if (wr == 0) PG8_BAR; }
    PG8_BAR;
    if constexpr (Epi::AFTER_DRAIN) { E.fused(acc, cur, wr, wc, fr, fq, lds, wid, lane); S.done(cur); }
#undef PG8_SA
#undef PG8_SB
#undef PG8_STAGE
#undef PG8_LDA
#undef PG8_LDB
#undef PG8_MMA
#undef PG8_WAIT_V
#undef PG8_WAIT_L
#undef PG8_BAR
#undef PG8_SCHED
}
}

namespace cg = cooperative_groups;
using pg8::bf16_t; using pg8::bf16x8; using pg8::f32x4; using pg8::u32x4; using pg8::cvt_pk_bf16;
#define LAS __attribute__((address_space(3)))
typedef unsigned u32x2 __attribute__((ext_vector_type(2)));

constexpr int T_TOK = 98304, T_PROMPT = 65536, DM = 1024, NMEMROWS = 5120, DFF = 2816;
constexpr int NCHUNK = T_TOK / 128;
constexpr float EPSF = 1e-6f;
constexpr int TS = 272;
constexpr int TILEB = 128 * TS;
constexpr int TS2 = 528;
constexpr int XBST_OFF = 4 * TILEB;
constexpr int LDS_BYTES = 4 * TILEB + 16;

constexpr size_t al256(size_t x) { return (x + 255) & ~(size_t)255; }
constexpr size_t WS_WIN = 0;
constexpr size_t WS_WINV = WS_WIN + (size_t)2560 * 1024 * 2;
constexpr size_t WS_WOUT = WS_WINV + (size_t)512 * 1024 * 2;
constexpr size_t WS_WQ = WS_WOUT + (size_t)1024 * 1024 * 2;
constexpr size_t WS_WKV = WS_WQ + (size_t)1024 * 1024 * 2;
constexpr size_t WS_WO = WS_WKV + (size_t)2048 * 1024 * 2;
constexpr size_t WS_WGU = WS_WO + (size_t)1024 * 1024 * 2;
constexpr size_t WS_WDN = WS_WGU + (size_t)5632 * 1024 * 2;
constexpr size_t WS_SGUW = WS_WDN + (size_t)1024 * 2816 * 2;
constexpr size_t WS_COS = WS_SGUW + (size_t)4 * 128 * 128 * 2;
constexpr size_t WS_SIN = WS_COS + (size_t)8192 * 64 * 4;
constexpr size_t WS_MEMN = WS_SIN + (size_t)8192 * 64 * 4;
constexpr size_t WS_KX = WS_MEMN + (size_t)NMEMROWS * 1024 * 2;
constexpr size_t WS_VXT = WS_KX + (size_t)NMEMROWS * 1024 * 2;
constexpr size_t WS_RS2 = al256(WS_VXT + (size_t)NMEMROWS * 1024 * 2);
constexpr size_t WS_RS5 = WS_RS2 + (size_t)98304 * 4;
constexpr size_t WS_BAR = WS_RS5 + (size_t)98304 * 4;
constexpr size_t WS_GCNT = WS_BAR + 16384;
constexpr size_t WS_BUFA = al256(WS_BAR + 32768);
constexpr size_t USZ = (size_t)T_TOK * 1024 * 2;
constexpr size_t HSZ = USZ / 2;
constexpr size_t WS_Z = WS_BUFA + USZ;
constexpr size_t WS_FF = al256(WS_Z + (size_t)98304 * 2816 * 2);
constexpr size_t WS_END = WS_FF + USZ;

struct Params {
    const float* x_p; const float* x_s; const float* mem_p; const float* mem_s; const float* norm_w; const float* w_in; const float* lg; const float* gn_w;
    const float* sgu_nw; const float* sgu_w; const float* sgu_b; const float* w_out; const float* wq; const float* wkv; const float* wo; const float* wgu; const float* wdn;
    float* out; unsigned char* ws; int lo, hi;
};

__device__ __forceinline__ float lo_bf(unsigned w) { return __uint_as_float(w << 16); }
__device__ __forceinline__ float hi_bf(unsigned w) { return __uint_as_float(w & 0xffff0000u); }
__device__ __forceinline__ float fast_exp2(float x) { return __builtin_amdgcn_exp2f(x); }
__device__ __forceinline__ float silu_f(float x) { return x * __builtin_amdgcn_rcpf(1.0f + fast_exp2(-1.4426950408889634f * x)); }
__device__ __forceinline__ float gelu_tanh_f(float x) { const float y = 0.7978845608028654f * (x + 0.044715f * x * x * x); return x * __builtin_amdgcn_rcpf(1.0f + fast_exp2(-2.885390081777927f * y)); }
__device__ __forceinline__ float wave_sum(float v) {
#pragma unroll
    for (int o = 32; o >= 1; o >>= 1) v += __shfl_xor(v, o);
    return v;
}
__device__ __forceinline__ const float* xrow(const Params& p, int t) { return t < T_PROMPT ? p.x_p + (size_t)t * DM : p.x_s + (size_t)(t - T_PROMPT) * DM; }

struct EpiPlain {
    static constexpr bool PERM = true, AFTER_DRAIN = false;
    bf16_t* O; size_t ldc; float scale;
    __device__ __forceinline__ void operator()(const f32x4 (&acc)[2][2][4][2], const pg8::Unit& u, int wr, int wc, int fr_, int fq_) const {
        int t_ = threadIdx.x; asm volatile("" : "+v"(t_)); const int fr = t_ & 15, fq = (t_ >> 4) & 3;
        const int row0 = u.pm * 256 + wr * 64 + fr, col0 = u.pn * 256 + wc * 32 + 8 * fq;
#pragma unroll
        for (int ai = 0; ai < 2; ++ai)
#pragma unroll
            for (int m = 0; m < 4; ++m) { bf16_t* rowp = O + (size_t)(row0 + ai * 128 + m * 16) * ldc + col0;
#pragma unroll
                for (int bj = 0; bj < 2; ++bj) { const f32x4 v0 = acc[ai][bj][m][0] * scale, v1 = acc[ai][bj][m][1] * scale;
                    u32x4 w; w.x = cvt_pk_bf16(v0[0], v0[1]); w.y = cvt_pk_bf16(v0[2], v0[3]); w.z = cvt_pk_bf16(v1[0], v1[1]); w.w = cvt_pk_bf16(v1[2], v1[3]);
                    *(u32x4*)(rowp + bj * 128) = w; } }
    }
};
struct EpiG1A {
    static constexpr bool PERM = true, AFTER_DRAIN = false;
    bf16_t* zb; const float* cosT; const float* sinT;
    __device__ __forceinline__ void operator()(const f32x4 (&acc)[2][2][4][2], const pg8::Unit& u, int wr, int wc, int fr_, int fq_) const {
        int t_ = threadIdx.x; asm volatile("" : "+v"(t_));
        const int fr = t_ & 15, fq = (t_ >> 4) & 3;
        const int part = u.pn >> 1, half = u.pn & 1;
        const int row0 = u.pm * 256 + wr * 64 + fr, cb = half * 256 + wc * 32 + 8 * fq;
        bf16_t* O = zb + (size_t)part * ((size_t)T_TOK * 512);
        if (part < 2) {
            const int j0 = 16 * wc + 4 * fq;
#pragma unroll
            for (int ai = 0; ai < 2; ++ai)
#pragma unroll
                for (int m = 0; m < 4; ++m) { const int row = row0 + ai * 128 + m * 16; const int pos = row & (row < T_PROMPT ? 4095 : 8191);
                    const f32x4 c4 = *(const f32x4*)(cosT + pos * 64 + j0), s4 = *(const f32x4*)(sinT + pos * 64 + j0);
#pragma unroll
                    for (int bj = 0; bj < 2; ++bj) { const f32x4 v0 = acc[ai][bj][m][0], v1 = acc[ai][bj][m][1];
                        const f32x4 o1 = v0 * c4 - v1 * s4, o2 = v0 * s4 + v1 * c4;
                        u32x4 w; w.x = cvt_pk_bf16(o1[0], o1[1]); w.y = cvt_pk_bf16(o1[2], o1[3]); w.z = cvt_pk_bf16(o2[0], o2[1]); w.w = cvt_pk_bf16(o2[2], o2[3]);
                        *(u32x4*)(O + (size_t)row * 512 + cb + bj * 128) = w; }
                    if (m == 3) asm volatile("" ::: "memory"); }
        } else {
#pragma unroll
            for (int ai = 0; ai < 2; ++ai)
#pragma unroll
                for (int m = 0; m < 4; ++m) { const int row = row0 + ai * 128 + m * 16;
#pragma unroll
                    for (int bj = 0; bj < 2; ++bj) { f32x4 v0 = acc[ai][bj][m][0], v1 = acc[ai][bj][m][1];
                        if (part == 2) {
#pragma unroll
                            for (int j = 0; j < 4; ++j) { v0[j] = silu_f(v0[j]); v1[j] = silu_f(v1[j]); }
                        } else {
#pragma unroll
                            for (int j = 0; j < 4; ++j) { v0[j] = gelu_tanh_f(v0[j]); v1[j] = gelu_tanh_f(v1[j]); }
                        }
                        u32x4 w; w.x = cvt_pk_bf16(v0[0], v0[1]); w.y = cvt_pk_bf16(v0[2], v0[3]); w.z = cvt_pk_bf16(v1[0], v1[1]); w.w = cvt_pk_bf16(v1[2], v1[3]);
                        *(u32x4*)(O + (size_t)row * 512 + cb + bj * 128) = w; } }
        }
    }
};
struct EpiPlainRS {
    static constexpr bool PERM = true, AFTER_DRAIN = false;
    bf16_t* O; size_t ldc; float scale; const float* rs;
    __device__ __forceinline__ void operator()(const f32x4 (&acc)[2][2][4][2], const pg8::Unit& u, int wr, int wc, int fr_, int fq_) const {
        int t_ = threadIdx.x; asm volatile("" : "+v"(t_)); const int fr = t_ & 15, fq = (t_ >> 4) & 3;
        const int row0 = u.pm * 256 + wr * 64 + fr, col0 = u.pn * 256 + wc * 32 + 8 * fq;
#pragma unroll
        for (int ai = 0; ai < 2; ++ai)
#pragma unroll
            for (int m = 0; m < 4; ++m) { const int row = row0 + ai * 128 + m * 16; const float r = rs[row] * scale; bf16_t* rowp = O + (size_t)row * ldc + col0;
#pragma unroll
                for (int bj = 0; bj < 2; ++bj) { const f32x4 v0 = acc[ai][bj][m][0] * r, v1 = acc[ai][bj][m][1] * r;
                    u32x4 w; w.x = cvt_pk_bf16(v0[0], v0[1]); w.y = cvt_pk_bf16(v0[2], v0[3]); w.z = cvt_pk_bf16(v1[0], v1[1]); w.w = cvt_pk_bf16(v1[2], v1[3]);
                    *(u32x4*)(rowp + bj * 128) = w; } }
    }
};
struct EpiGU {
    static constexpr bool PERM = true, AFTER_DRAIN = false;
    bf16_t* O; const float* rs;
    __device__ __forceinline__ void operator()(const f32x4 (&acc)[2][2][4][2], const pg8::Unit& u, int wr, int wc, int fr_, int fq_) const {
        int t_ = threadIdx.x; asm volatile("" : "+v"(t_)); const int fr = t_ & 15, fq = (t_ >> 4) & 3;
        const int row0 = u.pm * 256 + wr * 64 + fr, col0 = u.pn * 128 + wc * 32 + 8 * fq;
#pragma unroll
        for (int ai = 0; ai < 2; ++ai)
#pragma unroll
            for (int m = 0; m < 4; ++m) { const float r = rs[row0 + ai * 128 + m * 16]; const f32x4 g0 = acc[ai][0][m][0] * r, g1 = acc[ai][0][m][1] * r, u0 = acc[ai][1][m][0] * r, u1 = acc[ai][1][m][1] * r; f32x4 o0, o1;
#pragma unroll
                for (int j = 0; j < 4; ++j) { o0[j] = silu_f(g0[j]) * u0[j]; o1[j] = silu_f(g1[j]) * u1[j]; }
                u32x4 w; w.x = cvt_pk_bf16(o0[0], o0[1]); w.y = cvt_pk_bf16(o0[2], o0[3]); w.z = cvt_pk_bf16(o1[0], o1[1]); w.w = cvt_pk_bf16(o1[2], o1[3]);
                *(u32x4*)(O + (size_t)(row0 + ai * 128 + m * 16) * DFF + col0) = w; }
    }
};

__device__ __forceinline__ f32x4 zero_acc() { f32x4 a = {0.f, 0.f, 0.f, 0.f}; asm volatile("" : "+v"(a)); return a; }
template <int NI, int KS> __device__ __forceinline__ void mm_ra(f32x4 (&acc)[NI], const bf16x8 (&a)[KS], const LAS unsigned char* B, int ldb, int fr, int fq) {
#pragma unroll
    for (int ks = 0; ks < KS; ++ks)
#pragma unroll
        for (int ni = 0; ni < NI; ++ni) { const bf16x8 b = *(const LAS bf16x8*)(B + (16 * ni + fr) * ldb + (32 * ks + 8 * fq) * 2);
            acc[ni] = __builtin_amdgcn_mfma_f32_16x16x32_bf16(b, a[ks], acc[ni], 0, 0, 0); }
}
template <int KS> __device__ __forceinline__ void ld_afrag_lds(bf16x8 (&a)[KS], const LAS unsigned char* A, int lda, int fr, int fq) {
#pragma unroll
    for (int ks = 0; ks < KS; ++ks) a[ks] = *(const LAS bf16x8*)(A + fr * lda + (32 * ks + 8 * fq) * 2);
}

__device__ __forceinline__ int rotmap(int r) { return 64 * ((r >> 2) & 1) + 16 * (r >> 5) + 4 * ((r >> 3) & 3) + (r & 3); }
__device__ __forceinline__ int win_main_col(int s) {
    const int part = s >> 9, c = s & 511;
    if (part < 2) return part * 512 + (c & ~127) + rotmap(c & 127);
    return (part + 1) * 512 + c;
}
template <int JOB> __device__ __forceinline__ void wtile_load(float (&v)[8], const float* W, int ldw, int k0, int s0, const float* ksc, int tid) {
#pragma unroll
    for (int it = 0; it < 8; ++it) { const int idx = tid + 512 * it, kk = idx >> 6, ss = idx & 63, s = s0 + ss; int col;
        if (JOB == 0) col = win_main_col(s);
        else if (JOB == 1) col = 1024 + s;
        else if (JOB == 2) { const int pn = s >> 8, r = s & 255; col = (r >> 7) * DFF + 128 * pn + (r & 127); }
        else col = s;
        float wv = W[(size_t)(k0 + kk) * ldw + col]; if (JOB == 0 && (s >> 9) == 1) wv *= 0.08838834764831845f;
        if (ksc) wv *= ksc[k0 + kk];
        v[it] = wv; }
}
template <int JOB> __device__ __forceinline__ void wjob(LAS float* tl, const float* W, int ldw, bf16_t* Bt, int K, int nslots, int& base, const float* ksc = nullptr) {
    int tid_l = threadIdx.x; asm volatile("" : "+v"(tid_l)); const int tid = tid_l;
    const int nkt = K / 64, nst = nslots / 64, ntile = nkt * nst;
    int first = (int)blockIdx.x - (base % (int)gridDim.x); if (first < 0) first += gridDim.x;
    float v[8];
    if (first < ntile) wtile_load<JOB>(v, W, ldw, (first % nkt) * 64, (first / nkt) * 64, ksc, tid);
    for (int t = first; t < ntile; t += gridDim.x) {
        const int k0 = (t % nkt) * 64, s0 = (t / nkt) * 64;
#pragma unroll
        for (int it = 0; it < 8; ++it) { const int idx = tid + 512 * it; tl[(idx >> 6) * 65 + (idx & 63)] = v[it]; }
        __syncthreads();
        const int tn = t + (int)gridDim.x;
        if (tn < ntile) wtile_load<JOB>(v, W, ldw, (tn % nkt) * 64, (tn / nkt) * 64, ksc, tid);
        { const int ss = tid >> 3, kg = tid & 7; float x[8];
#pragma unroll
          for (int q = 0; q < 8; ++q) x[q] = tl[(8 * kg + q) * 65 + ss];
          u32x4 w; w.x = cvt_pk_bf16(x[0], x[1]); w.y = cvt_pk_bf16(x[2], x[3]); w.z = cvt_pk_bf16(x[4], x[5]); w.w = cvt_pk_bf16(x[6], x[7]);
          *(u32x4*)(Bt + (size_t)(s0 + ss) * K + k0 + 8 * kg) = w; }
        __syncthreads();
    }
    base += ntile;
}
__device__ __forceinline__ void rms_row_to_bf16(const float* src, const float* w, bf16_t* dst, int lane) {
    f32x4 v[4]; float ss = 0.f;
#pragma unroll
    for (int i = 0; i < 4; ++i) { v[i] = *(const f32x4*)(src + lane * 4 + 256 * i); ss += v[i][0] * v[i][0] + v[i][1] * v[i][1] + v[i][2] * v[i][2] + v[i][3] * v[i][3]; }
    ss = wave_sum(ss);
    const float r = 1.0f / sqrtf(ss * (1.0f / 1024.0f) + EPSF);
#pragma unroll
    for (int i = 0; i < 4; ++i) { const f32x4 wv = *(const f32x4*)(w + lane * 4 + 256 * i); const f32x4 o = v[i] * r * wv;
        u32x2 pk; pk.x = cvt_pk_bf16(o[0], o[1]); pk.y = cvt_pk_bf16(o[2], o[3]); *(u32x2*)(dst + lane * 4 + 256 * i) = pk; }
}
__device__ __forceinline__ void phase_prep(const Params& p, LAS unsigned char* lds) {
    unsigned char* ws = p.ws; LAS float* tl = (LAS float*)lds;
    int base = 0;
    wjob<0>(tl, p.w_in, 3072, (bf16_t*)(ws + WS_WIN), 1024, 2560, base);
    wjob<1>(tl, p.w_in, 3072, (bf16_t*)(ws + WS_WINV), 1024, 512, base);
    wjob<3>(tl, p.w_out, 1024, (bf16_t*)(ws + WS_WOUT), 1024, 1024, base);
    wjob<3>(tl, p.wq, 1024, (bf16_t*)(ws + WS_WQ), 1024, 1024, base, p.norm_w + 2 * DM);
    wjob<3>(tl, p.wkv, 2048, (bf16_t*)(ws + WS_WKV), 1024, 2048, base);
    wjob<3>(tl, p.wo, 1024, (bf16_t*)(ws + WS_WO), 1024, 1024, base);
    wjob<2>(tl, p.wgu, 2 * DFF, (bf16_t*)(ws + WS_WGU), 1024, 2 * DFF, base, p.norm_w + 5 * DM);
    wjob<3>(tl, p.wdn, 1024, (bf16_t*)(ws + WS_WDN), DFF, 1024, base);
    const int gtid = blockIdx.x * 512 + threadIdx.x, gsz = gridDim.x * 512;
    { bf16_t* o = (bf16_t*)(ws + WS_SGUW); for (int i = gtid; i < 4 * 128 * 128 / 2; i += gsz) { const float a = p.sgu_w[2 * i], b = p.sgu_w[2 * i + 1]; ((unsigned*)o)[i] = cvt_pk_bf16(a, b); } }
    { float* ct = (float*)(ws + WS_COS); float* st = (float*)(ws + WS_SIN);
      for (int i = gtid; i < 8192 * 64; i += gsz) { const int pos = i >> 6, j = i & 63;
          const float inv = exp2f(-(float)j * (13.287712379549449f / 64.0f));
          const float ang = (float)pos * inv;
          const double rev = (double)ang * 0.15915494309189535; const float fr_ = (float)(rev - rint(rev));
          ct[i] = __builtin_amdgcn_cosf(fr_); st[i] = __builtin_amdgcn_sinf(fr_); } }
    { const int wid = threadIdx.x >> 6, lane = threadIdx.x & 63; const int gw = blockIdx.x * 8 + wid, nw = gridDim.x * 8;
      bf16_t* hb = (bf16_t*)(ws + WS_BUFA); bf16_t* mn = (bf16_t*)(ws + WS_MEMN);
      for (int r0 = 4 * gw; r0 < T_TOK + NMEMROWS; r0 += 4 * nw) {
          const float* src[4]; const float* wn; bf16_t* dst[4];
#pragma unroll
          for (int k = 0; k < 4; ++k) { const int r = r0 + k;
              if (r < T_TOK) { src[k] = xrow(p, r); dst[k] = hb + (size_t)r * DM; }
              else { const int m = r - T_TOK; src[k] = m < 4096 ? p.mem_p + (size_t)m * DM : p.mem_s + (size_t)(m - 4096) * DM; dst[k] = mn + (size_t)m * DM; } }
          wn = r0 < T_TOK ? p.norm_w + 0 * DM : p.norm_w + 4 * DM;
          f32x4 v[4][4]; float ss[4];
#pragma unroll
          for (int k = 0; k < 4; ++k)
#pragma unroll
              for (int i = 0; i < 4; ++i) v[k][i] = *(const f32x4*)(src[k] + lane * 4 + 256 * i);
#pragma unroll
          for (int k = 0; k < 4; ++k) { ss[k] = 0.f;
#pragma unroll
              for (int i = 0; i < 4; ++i) ss[k] += v[k][i][0] * v[k][i][0] + v[k][i][1] * v[k][i][1] + v[k][i][2] * v[k][i][2] + v[k][i][3] * v[k][i][3];
              ss[k] = wave_sum(ss[k]); }
#pragma unroll
          for (int k = 0; k < 4; ++k) { const float rr = 1.0f / sqrtf(ss[k] * (1.0f / 1024.0f) + EPSF);
#pragma unroll
              for (int i = 0; i < 4; ++i) { const f32x4 wv = *(const f32x4*)(wn + lane * 4 + 256 * i); const f32x4 o = v[k][i] * rr * wv;
                  u32x2 pk; pk.x = cvt_pk_bf16(o[0], o[1]); pk.y = cvt_pk_bf16(o[2], o[3]); *(u32x2*)(dst[k] + lane * 4 + 256 * i) = pk; } } } }
    __syncthreads();
}

__device__ __forceinline__ void phase_r1(const Params& p, LAS unsigned char* lds) {
    int tid_l = threadIdx.x; asm volatile("" : "+v"(tid_l)); const int tid = tid_l, wid = tid >> 6, lane = tid & 63, fr = lane & 15, fq = lane >> 4;
    const bf16_t* kb = (const bf16_t*)(p.ws + WS_Z + 1 * HSZ); const bf16_t* vt = (const bf16_t*)(p.ws + WS_Z + 5 * HSZ);
    bf16_t* wb = (bf16_t*)p.out;
    LAS unsigned char* KfT = lds; LAS unsigned char* KbT = lds + TILEB; LAS unsigned char* VT = lds + 2 * TILEB;
    const int jp = tid & 63;
    const int NU = NCHUNK * 4;
    u32x4 RK[2][2], RV[4];
#define R1_LOAD(uu) do { const int cg_ = (uu) >> 2, h_ = (uu) & 3; const size_t t0_ = (size_t)cg_ * 128; \
        _Pragma("unroll") for (int it = 0; it < 2; ++it) { const int c = (tid >> 6) + 8 * it; \
            RK[it][0] = *(const u32x4*)(kb + (t0_ + 2 * jp) * 512 + h_ * 128 + 8 * c); RK[it][1] = *(const u32x4*)(kb + (t0_ + 2 * jp + 1) * 512 + h_ * 128 + 8 * c); } \
        _Pragma("unroll") for (int it = 0; it < 4; ++it) { const int id = tid + 512 * it, r = id >> 4, c = id & 15; \
            RV[it] = *(const u32x4*)(vt + (size_t)(h_ * 128 + r) * T_TOK + t0_ + 8 * c); } } while (0)
    int u = blockIdx.x;
    if (u < NU) R1_LOAD(u);
    for (; u < NU; u += gridDim.x) {
        const int cgi = u >> 2, h = u & 3;
        const float lf2 = p.lg[h] * 1.4426950408889634f, lb2 = p.lg[4 + h] * 1.4426950408889634f;
        const float ff0 = fast_exp2(lf2 * (float)(127 - 2 * jp)), ff1 = fast_exp2(lf2 * (float)(126 - 2 * jp));
        const float fb0 = fast_exp2(lb2 * (float)(2 * jp)), fb1 = fast_exp2(lb2 * (float)(2 * jp + 1));
#pragma unroll
        for (int it = 0; it < 2; ++it) { const int c = (tid >> 6) + 8 * it; const u32x4 r0 = RK[it][0], r1 = RK[it][1];
#pragma unroll
            for (int q = 0; q < 8; ++q) { const unsigned w0 = r0[q >> 1], w1 = r1[q >> 1];
                const float e0 = (q & 1) ? hi_bf(w0) : lo_bf(w0), e1 = (q & 1) ? hi_bf(w1) : lo_bf(w1);
                *(LAS unsigned*)(KfT + (8 * c + q) * TS + 4 * jp) = cvt_pk_bf16(e0 * ff0, e1 * ff1);
                *(LAS unsigned*)(KbT + (8 * c + q) * TS + 4 * jp) = cvt_pk_bf16(e0 * fb0, e1 * fb1); } }
#pragma unroll
        for (int it = 0; it < 4; ++it) { const int id = tid + 512 * it, r = id >> 4, c = id & 15; *(LAS u32x4*)(VT + r * TS + c * 16) = RV[it]; }
        __syncthreads();
        if (u + (int)gridDim.x < NU) R1_LOAD(u + (int)gridDim.x);
        bf16x8 a[4]; ld_afrag_lds<4>(a, VT + 16 * wid * TS, TS, fr, fq);
#pragma unroll
        for (int dir = 0; dir < 2; ++dir) {
            f32x4 acc[8];
#pragma unroll
            for (int ni = 0; ni < 8; ++ni) acc[ni] = zero_acc();
            mm_ra<8, 4>(acc, a, dir ? KbT : KfT, TS, fr, fq);
            bf16_t* o = wb + ((size_t)(dir * NCHUNK + cgi) * 4 + h) * 16384 + (16 * wid + fr) * 128 + 4 * fq;
#pragma unroll
            for (int ni = 0; ni < 8; ++ni) { u32x2 pk; pk.x = cvt_pk_bf16(acc[ni][0], acc[ni][1]); pk.y = cvt_pk_bf16(acc[ni][2], acc[ni][3]); *(u32x2*)(o + 16 * ni) = pk; }
        }
        __syncthreads();
    }
#undef R1_LOAD
}
__device__ __forceinline__ void phase_sgu(const Params& p, LAS unsigned char* lds) {
    int tid_l = threadIdx.x; asm volatile("" : "+v"(tid_l)); const int tid = tid_l, wid = tid >> 6, lane = tid & 63, fr = lane & 15, fq = lane >> 4;
    const bf16_t* ub = (const bf16_t*)(p.ws + WS_Z + 3 * HSZ); const bf16_t* vsb = (const bf16_t*)(p.ws + WS_Z + 4 * HSZ);
    const bf16_t* sw = (const bf16_t*)(p.ws + WS_SGUW); bf16_t* mixed = (bf16_t*)(p.ws + WS_BUFA);
    LAS unsigned char* VnT = lds; LAS float* stat = (LAS float*)(lds + TILEB);
    const int jp = tid & 63;
    for (int cgi = blockIdx.x; cgi < NCHUNK; cgi += gridDim.x) {
        const size_t t0 = (size_t)cgi * 128;
        u32x4 TR[2][2]; bf16x8 a[4], an[4];
#define SGU_LOADT(g) do { _Pragma("unroll") for (int it = 0; it < 2; ++it) { const int c = (tid >> 6) + 8 * it; \
            TR[it][0] = *(const u32x4*)(vsb + (t0 + 2 * jp) * 512 + (g) * 128 + 8 * c); TR[it][1] = *(const u32x4*)(vsb + (t0 + 2 * jp + 1) * 512 + (g) * 128 + 8 * c); } } while (0)
#define SGU_LOADA(g, AD) do { _Pragma("unroll") for (int ks = 0; ks < 4; ++ks) AD[ks] = *(const bf16x8*)(sw + (size_t)(g) * 16384 + (16 * wid + fr) * 128 + 32 * ks + 8 * fq); } while (0)
        SGU_LOADT(0); SGU_LOADA(0, a);
        { const int q = tid >> 2, part = tid & 3; float sm = 0.f, s2 = 0.f;
#pragma unroll
          for (int c = 0; c < 16; ++c) { const u32x4 r = *(const u32x4*)(vsb + (t0 + q) * 512 + part * 128 + 8 * c);
#pragma unroll
              for (int k = 0; k < 4; ++k) { const float x0 = lo_bf(r[k]), x1 = hi_bf(r[k]); sm += x0 + x1; s2 += x0 * x0 + x1 * x1; } }
          sm += __shfl_xor(sm, 1); sm += __shfl_xor(sm, 2); s2 += __shfl_xor(s2, 1); s2 += __shfl_xor(s2, 2);
          const float mu = sm * (1.0f / 512.0f), var = fmaxf(s2 * (1.0f / 512.0f) - mu * mu, 0.f);
          if (part == 0) { stat[2 * q] = mu; stat[2 * q + 1] = 1.0f / sqrtf(var + EPSF); } }
        __syncthreads();
        const float mu0 = stat[4 * jp], rs0 = stat[4 * jp + 1], mu1 = stat[4 * jp + 2], rs1 = stat[4 * jp + 3];
#pragma unroll
        for (int g = 0; g < 4; ++g) {
#pragma unroll
            for (int it = 0; it < 2; ++it) { const int c = (tid >> 6) + 8 * it; const u32x4 r0 = TR[it][0], r1 = TR[it][1];
                const f32x4 wa = *(const f32x4*)(p.sgu_nw + g * 128 + 8 * c), wb_ = *(const f32x4*)(p.sgu_nw + g * 128 + 8 * c + 4);
#pragma unroll
                for (int q = 0; q < 8; ++q) { const unsigned w0 = r0[q >> 1], w1 = r1[q >> 1]; const float wq_ = q < 4 ? wa[q & 3] : wb_[q & 3];
                    const float e0 = (q & 1) ? hi_bf(w0) : lo_bf(w0), e1 = (q & 1) ? hi_bf(w1) : lo_bf(w1);
                    *(LAS unsigned*)(VnT + (8 * c + q) * TS + 4 * jp) = cvt_pk_bf16((e0 - mu0) * rs0 * wq_, (e1 - mu1) * rs1 * wq_); } }
            __syncthreads();
            if (g < 3) { SGU_LOADT(g + 1); SGU_LOADA(g + 1, an); }
            const int prow = 16 * wid + fr; const float bias = p.sgu_b[g * 128 + prow];
            const bf16_t* up = ub + (t0 + prow) * 512 + g * 128 + 4 * fq; bf16_t* op = mixed + (t0 + prow) * 1024 + 512 + g * 128 + 4 * fq;
            u32x2 UU[8];
#pragma unroll
            for (int ni = 0; ni < 8; ++ni) UU[ni] = *(const u32x2*)(up + 16 * ni);
            f32x4 acc[8];
#pragma unroll
            for (int ni = 0; ni < 8; ++ni) acc[ni] = zero_acc();
            mm_ra<8, 4>(acc, a, VnT, TS, fr, fq);
#pragma unroll
            for (int ni = 0; ni < 8; ++ni) { const u32x2 uu = UU[ni];
                u32x2 pk; pk.x = cvt_pk_bf16((acc[ni][0] + bias) * lo_bf(uu.x), (acc[ni][1] + bias) * hi_bf(uu.x)); pk.y = cvt_pk_bf16((acc[ni][2] + bias) * lo_bf(uu.y), (acc[ni][3] + bias) * hi_bf(uu.y));
                *(u32x2*)(op + 16 * ni) = pk; }
            __syncthreads();
            if (g < 3) {
#pragma unroll
                for (int ks = 0; ks < 4; ++ks) a[ks] = an[ks];
            }
        }
#undef SGU_LOADT
#undef SGU_LOADA
    }
}
__device__ __forceinline__ void phase_scan(const Params& p) {
    const bf16_t* wb = (const bf16_t*)p.out; bf16_t* rb = (bf16_t*)p.out + USZ / 2;
    const int gtid = blockIdx.x * 512 + threadIdx.x, gsz = gridDim.x * 512;
    for (int item = gtid; item < 20 * 4 * 2 * 2048; item += gsz) {
        const int e8 = item & 2047, dir = (item >> 11) & 1, h = (item >> 12) & 3, s = item >> 14;
        const int cg0 = s < 16 ? s * 32 : 512 + (s - 16) * 64, n = s < 16 ? 32 : 64;
        const float dec = fast_exp2(p.lg[dir * 4 + h] * (128.0f * 1.4426950408889634f));
        float st[8];
#pragma unroll
        for (int k = 0; k < 8; ++k) st[k] = 0.f;
        for (int c0 = 0; c0 < n; c0 += 8) {
            u32x4 w[8];
#pragma unroll
            for (int k = 0; k < 8; ++k) { const int c = dir ? (n - 1 - (c0 + k)) : (c0 + k);
                w[k] = *(const u32x4*)(wb + ((size_t)(dir * NCHUNK + cg0 + c) * 4 + h) * 16384 + e8 * 8); }
#pragma unroll
            for (int k = 0; k < 8; ++k) { const int c = dir ? (n - 1 - (c0 + k)) : (c0 + k);
                u32x4 o;
#pragma unroll
                for (int q = 0; q < 4; ++q) { o[q] = cvt_pk_bf16(st[2 * q], st[2 * q + 1]);
                    st[2 * q] = dec * st[2 * q] + lo_bf(w[k][q]); st[2 * q + 1] = dec * st[2 * q + 1] + hi_bf(w[k][q]); }
                *(u32x4*)(rb + ((size_t)(dir * NCHUNK + cg0 + c) * 4 + h) * 16384 + e8 * 8) = o; }
        }
    }
}
__device__ __forceinline__ void phase_r3(const Params& p, LAS unsigned char* lds) {
    int tid_l = threadIdx.x; asm volatile("" : "+v"(tid_l)); const int tid = tid_l, wid = tid >> 6, lane = tid & 63, fr = lane & 15, fq = lane >> 4;
    const bf16_t* qb = (const bf16_t*)(p.ws + WS_Z); const bf16_t* kb = (const bf16_t*)(p.ws + WS_Z + 1 * HSZ); const bf16_t* gb = (const bf16_t*)(p.ws + WS_Z + 2 * HSZ);
    const bf16_t* vt = (const bf16_t*)(p.ws + WS_Z + 5 * HSZ); const bf16_t* wb = (const bf16_t*)p.out + USZ / 2; bf16_t* mixed = (bf16_t*)(p.ws + WS_BUFA);
    LAS unsigned char* Kt = lds; LAS unsigned char* VT = lds + TILEB; LAS unsigned char* Rf = lds + 2 * TILEB; LAS unsigned char* Rb = lds + 3 * TILEB;
    const int NU = NCHUNK * 4; const int i = 16 * wid + fr;
    u32x4 RT[2][4], RS[2][4]; bf16x8 qf[4];
#define R3_LOADQ(uu) do { const size_t t0_ = (size_t)((uu) >> 2) * 128; const int h_ = (uu) & 3; \
        _Pragma("unroll") for (int ks = 0; ks < 4; ++ks) qf[ks] = *(const bf16x8*)(qb + (t0_ + (16 * (tv >> 6) + (tv & 15))) * 512 + h_ * 128 + 32 * ks + 8 * ((tv >> 4) & 3)); } while (0)
#define R3_LOAD(uu) do { const int cg_ = (uu) >> 2, h_ = (uu) & 3; const size_t t0_ = (size_t)cg_ * 128; \
        _Pragma("unroll") for (int it = 0; it < 4; ++it) { const int id = tv + 512 * it, r = id >> 4, c = id & 15; \
            RT[0][it] = *(const u32x4*)(kb + (t0_ + r) * 512 + h_ * 128 + 8 * c); \
            RT[1][it] = *(const u32x4*)(vt + (size_t)(h_ * 128 + r) * T_TOK + t0_ + 8 * c); } } while (0)
    int u = blockIdx.x; int tv = tid; asm volatile("" : "+v"(tv));
    if (u < NU) { R3_LOAD(u); R3_LOADQ(u); }
    for (; u < NU; u += gridDim.x) {
        asm volatile("" : "+v"(tv));
        const int cgi = u >> 2, h = u & 3; const size_t t0 = (size_t)cgi * 128;
        const float lf2 = p.lg[h] * 1.4426950408889634f, lb2 = p.lg[4 + h] * 1.4426950408889634f;
#pragma unroll
        for (int it = 0; it < 4; ++it) { const int id = tv + 512 * it, r = id >> 4, c = id & 15;
            *(LAS u32x4*)(Kt + r * TS + c * 16) = RT[0][it]; *(LAS u32x4*)(VT + r * TS + c * 16) = RT[1][it]; }
#pragma unroll
        for (int it = 0; it < 4; ++it) { const int id = tv + 512 * it, r = id >> 4, c = id & 15;
            RS[0][it] = *(const u32x4*)(wb + ((size_t)(0 * NCHUNK + cgi) * 4 + h) * 16384 + r * 128 + 8 * c);
            RS[1][it] = *(const u32x4*)(wb + ((size_t)(1 * NCHUNK + cgi) * 4 + h) * 16384 + r * 128 + 8 * c); }
        __syncthreads();
        const bool more = u + (int)gridDim.x < NU;
        f32x4 S[8];
#pragma unroll
        for (int ni = 0; ni < 8; ++ni) S[ni] = zero_acc();
        mm_ra<8, 4>(S, qf, Kt, TS, fr, fq);
#pragma unroll
        for (int ni = 0; ni < 8; ++ni)
#pragma unroll
            for (int jj = 0; jj < 4; ++jj) { const int dist = i - (16 * ni + 4 * fq + jj); const float f = dist >= 0 ? fast_exp2(lf2 * (float)dist) : fast_exp2(lb2 * (float)(-dist)); S[ni][jj] *= f; }
        __builtin_amdgcn_sched_barrier(0);
        __syncthreads();
#pragma unroll
        for (int ni = 0; ni < 8; ++ni) { u32x2 pk; pk.x = cvt_pk_bf16(S[ni][0], S[ni][1]); pk.y = cvt_pk_bf16(S[ni][2], S[ni][3]); *(LAS u32x2*)(Kt + i * TS + (16 * ni + 4 * fq) * 2) = pk; }
#pragma unroll
        for (int it = 0; it < 4; ++it) { const int id = tv + 512 * it, r = id >> 4, c = id & 15;
            *(LAS u32x4*)(Rf + r * TS + c * 16) = RS[0][it]; *(LAS u32x4*)(Rb + r * TS + c * 16) = RS[1][it]; }
        __syncthreads();
        if (more) R3_LOAD(u + (int)gridDim.x);
        f32x4 Y[8];
#pragma unroll
        for (int ni = 0; ni < 8; ++ni) Y[ni] = zero_acc();
        { bf16x8 sa[4]; ld_afrag_lds<4>(sa, Kt + 16 * wid * TS, TS, fr, fq); mm_ra<8, 4>(Y, sa, VT, TS, fr, fq); }
        __builtin_amdgcn_sched_barrier(0);
        { f32x4 P[8];
#pragma unroll
          for (int ni = 0; ni < 8; ++ni) P[ni] = zero_acc();
          mm_ra<8, 4>(P, qf, Rf, TS, fr, fq);
          const float a = fast_exp2(lf2 * (float)(i + 1));
#pragma unroll
          for (int ni = 0; ni < 8; ++ni) Y[ni] += P[ni] * a; }
        __builtin_amdgcn_sched_barrier(0);
        { f32x4 P[8];
#pragma unroll
          for (int ni = 0; ni < 8; ++ni) P[ni] = zero_acc();
          mm_ra<8, 4>(P, qf, Rb, TS, fr, fq);
          const float b = fast_exp2(lb2 * (float)(128 - i));
#pragma unroll
          for (int ni = 0; ni < 8; ++ni) Y[ni] += P[ni] * b; }
        __builtin_amdgcn_sched_barrier(0);
        asm volatile("" ::: "memory");
        if (more) R3_LOADQ(u + (int)gridDim.x);
        float sm = 0.f;
#pragma unroll
        for (int ni = 0; ni < 8; ++ni) sm += (Y[ni][0] + Y[ni][1]) + (Y[ni][2] + Y[ni][3]);
        sm += __shfl_xor(sm, 16); sm += __shfl_xor(sm, 32);
        const float mu = sm * (1.0f / 128.0f); float q2 = 0.f;
#pragma unroll
        for (int ni = 0; ni < 8; ++ni) { const f32x4 d = Y[ni] - mu; q2 += (d[0] * d[0] + d[1] * d[1]) + (d[2] * d[2] + d[3] * d[3]); }
        q2 += __shfl_xor(q2, 16); q2 += __shfl_xor(q2, 32);
        const float rs = 1.0f / sqrtf(q2 * (1.0f / 128.0f) + EPSF);
        const bf16_t* gp = gb + (t0 + i) * 512 + h * 128 + 4 * fq; const float* gw = p.gn_w + h * 128 + 4 * fq; bf16_t* op = mixed + (t0 + i) * 1024 + h * 128 + 4 * fq;
#pragma unroll
        for (int ni = 0; ni < 8; ++ni) { const u32x2 gg = *(const u32x2*)(gp + 16 * ni); const f32x4 w4 = *(const f32x4*)(gw + 16 * ni); const f32x4 y = (Y[ni] - mu) * rs * w4;
            u32x2 pk; pk.x = cvt_pk_bf16(y[0] * lo_bf(gg.x), y[1] * hi_bf(gg.x)); pk.y = cvt_pk_bf16(y[2] * lo_bf(gg.y), y[3] * hi_bf(gg.y)); *(u32x2*)(op + 16 * ni) = pk; }
        __syncthreads();
    }
#undef R3_LOAD
#undef R3_LOADQ
}
template <int MODE> __device__ __forceinline__ void phase_norm(const Params& p, const bf16_t* y, const bf16_t* xbin, const float* wa, bf16_t* xb, float* rsn) {
    const int wid = threadIdx.x >> 6, lane = threadIdx.x & 63;
    const int gx = blockIdx.x & 7, gi = blockIdx.x >> 3, GN = ((int)gridDim.x - gx + 7) >> 3;
    const int gw = gi * 8 + wid, nw = GN * 8, rbase = gx * (T_TOK / 8), rend = rbase + T_TOK / 8;
    constexpr int NR = 4;
    for (int r0 = rbase + NR * gw; r0 < rend; r0 += NR * nw) {
        f32x4 yv[NR][4], xv[NR][4]; float ss[NR];
#pragma unroll
        for (int k = 0; k < NR; ++k) { const int r = r0 + k;
#pragma unroll
            for (int i = 0; i < 4; ++i) { const u32x2 w = *(const u32x2*)(y + (size_t)r * DM + lane * 4 + 256 * i); yv[k][i] = (f32x4){lo_bf(w.x), hi_bf(w.x), lo_bf(w.y), hi_bf(w.y)};
                if (MODE == 0) xv[k][i] = __builtin_nontemporal_load((const f32x4*)(xrow(p, r) + lane * 4 + 256 * i));
                else { const u32x2 xw = *(const u32x2*)(xbin + (size_t)r * DM + lane * 4 + 256 * i); xv[k][i] = (f32x4){lo_bf(xw.x), hi_bf(xw.x), lo_bf(xw.y), hi_bf(xw.y)}; } } }
#pragma unroll
        for (int k = 0; k < NR; ++k) { ss[k] = 0.f;
#pragma unroll
            for (int i = 0; i < 4; ++i) ss[k] += yv[k][i][0] * yv[k][i][0] + yv[k][i][1] * yv[k][i][1] + yv[k][i][2] * yv[k][i][2] + yv[k][i][3] * yv[k][i][3];
            ss[k] = wave_sum(ss[k]); }
#pragma unroll
        for (int k = 0; k < NR; ++k) { const int r = r0 + k; const float r1 = 1.0f / sqrtf(ss[k] * (1.0f / 1024.0f) + EPSF); float s2 = 0.f;
#pragma unroll
            for (int i = 0; i < 4; ++i) { const f32x4 wv = *(const f32x4*)(wa + lane * 4 + 256 * i); const f32x4 xo = xv[k][i] + yv[k][i] * r1 * wv;
                if (MODE == 2) __builtin_nontemporal_store(xo, (f32x4*)(p.out + (size_t)r * DM + lane * 4 + 256 * i));
                else { u32x2 pk; pk.x = cvt_pk_bf16(xo[0], xo[1]); pk.y = cvt_pk_bf16(xo[2], xo[3]); *(u32x2*)(xb + (size_t)r * DM + lane * 4 + 256 * i) = pk;
                       s2 += xo[0] * xo[0] + xo[1] * xo[1] + xo[2] * xo[2] + xo[3] * xo[3]; } }
            if (MODE != 2) { s2 = wave_sum(s2); if (lane == 0) rsn[r] = 1.0f / sqrtf(s2 * (1.0f / 1024.0f) + EPSF); } }
    }
}
__device__ __forceinline__ void phase_xattn(const Params& p, LAS unsigned char* lds) {
    int tid_l = threadIdx.x; asm volatile("" : "+v"(tid_l)); const int tid = tid_l, wid = tid >> 6, lane = tid & 63, fr = lane & 15, fq = lane >> 4;
    const bf16_t* qx = (const bf16_t*)(p.ws + WS_Z); const bf16_t* kx = (const bf16_t*)(p.ws + WS_KX); const bf16_t* vxt = (const bf16_t*)(p.ws + WS_VXT);
    bf16_t* ob = (bf16_t*)(p.ws + WS_BUFA);
    LAS unsigned char* RA = lds; LAS unsigned char* RP = lds + 2 * TILEB;
    const int NU = NCHUNK * 4; const int i = 16 * wid + fr;
    u32x4 R[8]; bf16x8 qf[8], qn[8];
#define XA_M0(uu) ((size_t)((((uu) >> 2) * 128 < T_PROMPT) ? ((((uu) >> 2) * 128) >> 12) : 16 + (((((uu) >> 2) * 128) - T_PROMPT) >> 13)) * 256)
#define XA_LOADK(uu, dh) do { const size_t m0_ = XA_M0(uu); const int h_ = (uu) & 3; \
        _Pragma("unroll") for (int it = 0; it < 8; ++it) { const int id = tid + 512 * it, r = id >> 4, c = id & 15; R[it] = *(const u32x4*)(kx + (m0_ + r) * 1024 + h_ * 256 + (dh) * 128 + 8 * c); } } while (0)
#define XA_LOADV(uu, dh) do { const size_t m0_ = XA_M0(uu); const int h_ = (uu) & 3; \
        _Pragma("unroll") for (int it = 0; it < 8; ++it) { const int id = tid + 512 * it, r = id >> 5, c = id & 31; R[it] = *(const u32x4*)(vxt + (size_t)(h_ * 256 + (dh) * 128 + r) * NMEMROWS + m0_ + 8 * c); } } while (0)
#define XA_STOREK() do { _Pragma("unroll") for (int it = 0; it < 8; ++it) { const int id = tid + 512 * it, r = id >> 4, c = id & 15; *(LAS u32x4*)(RA + r * TS + c * 16) = R[it]; } } while (0)
#define XA_STOREV() do { _Pragma("unroll") for (int it = 0; it < 8; ++it) { const int id = tid + 512 * it, r = id >> 5, c = id & 31; *(LAS u32x4*)(RA + r * TS2 + c * 16) = R[it]; } } while (0)
#define XA_LOADQ(uu, QD) do { const size_t t0_ = (size_t)((uu) >> 2) * 128; const int h_ = (uu) & 3; \
        _Pragma("unroll") for (int ks = 0; ks < 8; ++ks) QD[ks] = *(const bf16x8*)(qx + (t0_ + i) * 1024 + h_ * 256 + 32 * ks + 8 * fq); } while (0)
    const int gx = blockIdx.x & 7, gi = blockIdx.x >> 3, GN = ((int)gridDim.x - gx + 7) >> 3;
    const int UG = NU / 8, uend = (gx + 1) * UG;
    int u = gx * UG + gi;
    if (u < uend) { XA_LOADK(u, 0); XA_LOADQ(u, qf); }
    for (; u < uend; u += GN) {
        const int h = u & 3; const size_t t0 = (size_t)(u >> 2) * 128;
        f32x4 S[16];
#pragma unroll
        for (int ni = 0; ni < 16; ++ni) S[ni] = zero_acc();
        XA_STOREK(); __syncthreads(); XA_LOADK(u, 1);
        { bf16x8 a4[4];
#pragma unroll
          for (int ks = 0; ks < 4; ++ks) a4[ks] = qf[ks];
          mm_ra<16, 4>(S, a4, RA, TS, fr, fq); }
        __syncthreads();
        XA_STOREK(); __syncthreads(); XA_LOADV(u, 0);
        { bf16x8 a4[4];
#pragma unroll
          for (int ks = 0; ks < 4; ++ks) a4[ks] = qf[4 + ks];
          mm_ra<16, 4>(S, a4, RA, TS, fr, fq); }
        float mx = -3.0e38f;
#pragma unroll
        for (int ni = 0; ni < 16; ++ni) mx = fmaxf(mx, fmaxf(fmaxf(S[ni][0], S[ni][1]), fmaxf(S[ni][2], S[ni][3])));
        mx = fmaxf(mx, __shfl_xor(mx, 16)); mx = fmaxf(mx, __shfl_xor(mx, 32));
        float sum = 0.f;
#pragma unroll
        for (int ni = 0; ni < 16; ++ni) {
#pragma unroll
            for (int j = 0; j < 4; ++j) { const float e = fast_exp2((S[ni][j] - mx) * 1.4426950408889634f); S[ni][j] = e; sum += e; }
            u32x2 pk; pk.x = cvt_pk_bf16(S[ni][0], S[ni][1]); pk.y = cvt_pk_bf16(S[ni][2], S[ni][3]); *(LAS u32x2*)(RP + i * TS2 + (16 * ni + 4 * fq) * 2) = pk; }
        sum += __shfl_xor(sum, 16); sum += __shfl_xor(sum, 32);
        const float rinv = 1.0f / sum;
        __syncthreads();
        XA_STOREV(); __syncthreads(); XA_LOADV(u, 1);
        bf16x8 pa[8]; ld_afrag_lds<8>(pa, RP + 16 * wid * TS2, TS2, fr, fq);
        { f32x4 O[8];
#pragma unroll
          for (int ni = 0; ni < 8; ++ni) O[ni] = zero_acc();
          mm_ra<8, 8>(O, pa, RA, TS2, fr, fq);
          bf16_t* op = ob + (t0 + i) * 1024 + h * 256 + 4 * fq;
#pragma unroll
          for (int ni = 0; ni < 8; ++ni) { const f32x4 o = O[ni] * rinv; u32x2 pk; pk.x = cvt_pk_bf16(o[0], o[1]); pk.y = cvt_pk_bf16(o[2], o[3]); *(u32x2*)(op + 16 * ni) = pk; } }
        __syncthreads();
        XA_STOREV(); __syncthreads();
        const bool more = u + GN < uend;
        if (more) { XA_LOADK(u + GN, 0); XA_LOADQ(u + GN, qn); }
        { f32x4 O[8];
#pragma unroll
          for (int ni = 0; ni < 8; ++ni) O[ni] = zero_acc();
          mm_ra<8, 8>(O, pa, RA, TS2, fr, fq);
          bf16_t* op = ob + (t0 + i) * 1024 + h * 256 + 128 + 4 * fq;
#pragma unroll
          for (int ni = 0; ni < 8; ++ni) { const f32x4 o = O[ni] * rinv; u32x2 pk; pk.x = cvt_pk_bf16(o[0], o[1]); pk.y = cvt_pk_bf16(o[2], o[3]); *(u32x2*)(op + 16 * ni) = pk; } }
        __syncthreads();
        if (more) {
#pragma unroll
            for (int ks = 0; ks < 8; ++ks) qf[ks] = qn[ks];
        }
    }
#undef XA_M0
#undef XA_LOADK
#undef XA_LOADV
#undef XA_STOREK
#undef XA_STOREV
#undef XA_LOADQ
}

#define XB_TMO      128
#define XB_XCNT(j)  (256  + 64 * (j))
#define XB_XSUB(j)  (1280 + 64 * (j))
#define XB_XGEN(j)  (2304 + 64 * (j))
#define XB_TOP      3328
#define XB_TOPGEN   3392
#define XCD_BAR_WORDS 3456
#define XB_SPIN_CAP (1u << 18)
__device__ __forceinline__ unsigned xb_ld(unsigned* p)              { return __hip_atomic_load(p, __ATOMIC_RELAXED, __HIP_MEMORY_SCOPE_AGENT); }
__device__ __forceinline__ unsigned xb_add(unsigned* p, unsigned v) { return __hip_atomic_fetch_add(p, v, __ATOMIC_RELAXED, __HIP_MEMORY_SCOPE_AGENT); }
__device__ __forceinline__ unsigned xb_xcc_id() { return (unsigned)__builtin_amdgcn_s_getreg((3 << 11) | 20) & 0xFu; }
#define XB_SPIN(cond, bar) do { unsigned _sp = 0; while (cond) { __builtin_amdgcn_s_sleep(1); \
    if ((++_sp & 255u) == 0u) { if (xb_ld(&(bar)[XB_TMO])) break; if (_sp > XB_SPIN_CAP) { atomicAdd(&(bar)[XB_TMO], 1u); break; } } } } while (0)
struct XcdBarrier { unsigned* bar; unsigned x; volatile LAS unsigned* st; };
__device__ __forceinline__ XcdBarrier xcd_barrier_post(unsigned* bar, volatile LAS unsigned* st) {
    XcdBarrier b; b.bar = bar; b.x = xb_xcc_id(); b.st = st;
    if (threadIdx.x == 0) (void)xb_add(&bar[XB_XCNT(b.x)], 1u);
    return b;
}
__device__ __forceinline__ void xcd_barrier_complete(unsigned* bar, unsigned x, unsigned& nloc, unsigned& nx) {
    const unsigned G = gridDim.x * gridDim.y * gridDim.z;
    unsigned sum, cnt, mine, sp = 0u;
    for (;;) {
        sum = 0u; cnt = 0u; mine = 0u;
#pragma unroll
        for (unsigned j = 0; j < 16; ++j) { const unsigned c = xb_ld(&bar[XB_XCNT(j)]); sum += c; cnt += (c > 0u) ? 1u : 0u; mine = (j == x) ? c : mine; }
        if (sum == G) break;
        __builtin_amdgcn_s_sleep(1);
        if ((++sp & 255u) == 0u) { if (xb_ld(&bar[XB_TMO])) break; if (sp > XB_SPIN_CAP) { atomicAdd(&bar[XB_TMO], 1u); break; } }
    }
    nloc = mine > 0u ? mine : 1u; nx = cnt > 0u ? cnt : 1u;
}
__device__ __forceinline__ void xcd_barrier(const XcdBarrier& b) {
    asm volatile("s_waitcnt vmcnt(0)" ::: "memory");
    __syncthreads();
    if (threadIdx.x == 0) {
        unsigned* bar = b.bar;
        __builtin_amdgcn_s_waitcnt(0);
        unsigned nloc = b.st[0], nx = b.st[1];
        if (nloc == 0u) { xcd_barrier_complete(bar, b.x, nloc, nx); b.st[0] = nloc; b.st[1] = nx; }
        const unsigned old = xb_add(&bar[XB_XSUB(b.x)], 1u);
        const unsigned gen = old / nloc;
        if (old + 1u == (gen + 1u) * nloc) {
            __builtin_amdgcn_fence(__ATOMIC_RELEASE, "agent");
            asm volatile("s_waitcnt vmcnt(0)" ::: "memory");
            const unsigned og = xb_add(&bar[XB_TOP], 1u);
            const unsigned tg = og / nx;
            if (og + 1u == (tg + 1u) * nx) xb_add(&bar[XB_TOPGEN], 1u);
            else XB_SPIN(xb_ld(&bar[XB_TOPGEN]) == tg, bar);
            __builtin_amdgcn_fence(__ATOMIC_ACQUIRE, "agent");
            xb_add(&bar[XB_XGEN(b.x)], 1u);
            asm volatile("s_waitcnt vmcnt(0)" ::: "memory");
        } else {
            XB_SPIN(xb_ld(&bar[XB_XGEN(b.x)]) == gen, bar);
            __builtin_amdgcn_fence(__ATOMIC_ACQUIRE, "agent");
            asm volatile("s_waitcnt vmcnt(0)" ::: "memory");
        }
    }
    __syncthreads();
}
#ifdef PG8_V2
#ifndef PG8_ALIGN
#define PG8_ALIGN true
#endif
#ifndef PG8_SP2
#define PG8_SP2 true
#endif
#define GEMM_PHASE(EPI, g, S, E) pg8::gemm_phase<EPI, pg8::StaticOrder, PG8_ALIGN, PG8_SP2>(lds, g, S, E)
#else
#define GEMM_PHASE(EPI, g, S, E) pg8::gemm_phase<EPI, pg8::StaticOrder>(lds, g, S, E, nullptr)
#endif
__device__ __forceinline__ void grp_barrier(unsigned* cnt, unsigned target, unsigned* tmo) {
    asm volatile("s_waitcnt vmcnt(0)" ::: "memory");
    __syncthreads();
    if (threadIdx.x == 0) {
        __builtin_amdgcn_fence(__ATOMIC_RELEASE, "agent");
        asm volatile("s_waitcnt vmcnt(0)" ::: "memory");
        (void)xb_add(cnt, 1u);
        unsigned sp = 0;
        while (xb_ld(cnt) < target) { __builtin_amdgcn_s_sleep(1); if ((++sp & 255u) == 0u) { if (xb_ld(tmo)) break; if (sp > XB_SPIN_CAP) { atomicAdd(tmo, 1u); break; } } }
        __builtin_amdgcn_fence(__ATOMIC_ACQUIRE, "agent");
        asm volatile("s_waitcnt vmcnt(0)" ::: "memory");
    }
    __syncthreads();
}
enum { PH_PREP = 0, PH_G1A, PH_G1B, PH_GK, PH_GV, PH_MIX, PH_R1, PH_SCAN, PH_R3, PH_GOUT, PH_N1, PH_GQ, PH_XA, PH_GO, PH_N2, PH_GGU, PH_GDN, PH_N3, PH_COUNT };

__global__ void __launch_bounds__(512) fwd_megakernel(Params p) {
    extern __shared__ __attribute__((aligned(16))) unsigned char lds_raw[];
    LAS unsigned char* lds = (LAS unsigned char*)lds_raw;
    cg::grid_group grid = cg::this_grid();
    unsigned char* ws = p.ws;
    bf16_t* bufa = (bf16_t*)(ws + WS_BUFA); bf16_t* zb = (bf16_t*)(ws + WS_Z); bf16_t* z1 = (bf16_t*)(ws + WS_Z + USZ);
    const int G = gridDim.x, c = blockIdx.x;
    volatile LAS unsigned* xbst = (volatile LAS unsigned*)(lds + XBST_OFF);
    if (threadIdx.x == 0) { xbst[0] = 0u; xbst[1] = 0u; }
    __syncthreads();
    unsigned* const gcnt = (unsigned*)(ws + WS_GCNT) + 64 * (c & 7); const unsigned gsize = (unsigned)((G - (c & 7) + 7) >> 3); unsigned gk = 0;
    XcdBarrier xbar; xbar.bar = (unsigned*)(ws + WS_BAR); xbar.x = 0; xbar.st = xbst;
    if (p.hi - p.lo > 1) xbar = xcd_barrier_post((unsigned*)(ws + WS_BAR), xbst);
#define IN(k) (p.lo <= (k) && (k) < p.hi)
#define GSYNC() xcd_barrier(xbar)
#define SEAM(k) do { __syncthreads(); if (IN((k) + 1)) GSYNC(); } while (0)
#define GSEAM(k) do { __syncthreads(); if (IN((k) + 1)) { if (p.hi - p.lo > 1) { ++gk; grp_barrier(gcnt, gsize * gk, (unsigned*)(ws + WS_BAR) + XB_TMO); } } } while (0)
#define PLAINRS(gg, ee) do { const pg8::Gemm g_ = gg; const EpiPlainRS e_ = ee; pg8::StaticOrder S_; S_.init(g_.M, g_.N, G, c); GEMM_PHASE(EpiPlainRS, g_, S_, e_); } while (0)
#define PLAIN(gg, ee) do { const pg8::Gemm g_ = gg; const EpiPlain e_ = ee; pg8::StaticOrder S_; S_.init(g_.M, g_.N, G, c); GEMM_PHASE(EpiPlain, g_, S_, e_); } while (0)
#define ON(k) (!defined(ONLY_PH) || (ONLY_PH == (k)))
#ifndef DUP_MASK
#define DUP_MASK 0
#endif
#define REPS(k) for (int rep_ = 0; rep_ < 1 + ((DUP_MASK >> (k)) & 1); ++rep_)
#if ON(0)
    if (IN(PH_PREP)) { REPS(PH_PREP) { phase_prep(p, lds); } if (IN(PH_PREP + 1)) { __builtin_amdgcn_fence(__ATOMIC_RELEASE, "agent"); __syncthreads(); grid.sync(); } SEAM(PH_PREP); }
#endif
#if ON(1)
    if (IN(PH_G1A)) { pg8::Gemm g1{bufa, (const bf16_t*)(ws + WS_WIN), T_TOK, 2560, 1024}; pg8::StaticOrder S; S.init(T_TOK, 2560, G, c);
        EpiG1A E{zb, (const float*)(ws + WS_COS), (const float*)(ws + WS_SIN)};
        REPS(PH_G1A) { GEMM_PHASE(EpiG1A, g1, S, E); __syncthreads(); } }
#endif
#if ON(2)
    for (int s = PH_G1B; s <= PH_GK; ++s) if (IN(s)) {
        pg8::Gemm g; EpiPlain e; int cc = c;
        if (s == PH_G1B) { g = pg8::Gemm{(const bf16_t*)(ws + WS_WINV), bufa, 512, T_TOK, 1024}; e = EpiPlain{(bf16_t*)(ws + WS_Z + 5 * HSZ), (size_t)T_TOK, 1.0f}; }
        else if (c < 80 || c >= 160) { g = pg8::Gemm{(const bf16_t*)(ws + WS_MEMN), (const bf16_t*)(ws + WS_WKV), NMEMROWS, 1024, 1024}; e = EpiPlain{(bf16_t*)(ws + WS_KX), 1024, 1.0f}; }
        else { g = pg8::Gemm{(const bf16_t*)(ws + WS_WKV) + (size_t)1024 * 1024, (const bf16_t*)(ws + WS_MEMN), 1024, NMEMROWS, 1024}; e = EpiPlain{(bf16_t*)(ws + WS_VXT), (size_t)NMEMROWS, 1.0f}; cc = c - 80; }
        { const pg8::Gemm g_ = g; const EpiPlain e_ = e; pg8::StaticOrder S_; S_.init(g_.M, g_.N, G, cc); GEMM_PHASE(EpiPlain, g_, S_, e_); } __syncthreads();
        if (s == PH_GK && IN(PH_GK + 1)) GSYNC();
    }
#endif
#if ON(5)
    if (IN(PH_MIX)) { REPS(PH_MIX) { phase_sgu(p, lds); } }
    if (IN(PH_R1)) { REPS(PH_R1) { phase_r1(p, lds); } SEAM(PH_R1); }
#endif
#if ON(6)
    if (IN(PH_SCAN)) { phase_scan(p); SEAM(PH_SCAN); }
#endif
#if ON(7)
    if (IN(PH_R3)) { REPS(PH_R3) { phase_r3(p, lds); } SEAM(PH_R3); }
#endif
#if ON(8)
    if (IN(PH_GOUT)) { REPS(PH_GOUT) PLAIN((pg8::Gemm{bufa, (const bf16_t*)(ws + WS_WOUT), T_TOK, 1024, 1024}), (EpiPlain{zb, 1024, 1.0f})); GSEAM(PH_GOUT); }
#endif
#if ON(9)
    if (IN(PH_N1)) { REPS(PH_N1) { phase_norm<0>(p, zb, nullptr, p.norm_w + 1 * DM, z1, (float*)(ws + WS_RS2)); } GSEAM(PH_N1); }
#endif
#if ON(10)
    if (IN(PH_GQ)) { REPS(PH_GQ) PLAINRS((pg8::Gemm{z1, (const bf16_t*)(ws + WS_WQ), T_TOK, 1024, 1024}), (EpiPlainRS{zb, 1024, 0.0625f, (const float*)(ws + WS_RS2)})); GSEAM(PH_GQ); }
#endif
#if ON(11)
    if (IN(PH_XA)) { REPS(PH_XA) { phase_xattn(p, lds); } GSEAM(PH_XA); }
#endif
#if ON(12)
    if (IN(PH_GO)) { REPS(PH_GO) PLAIN((pg8::Gemm{bufa, (const bf16_t*)(ws + WS_WO), T_TOK, 1024, 1024}), (EpiPlain{zb, 1024, 1.0f})); GSEAM(PH_GO); }
#endif
#if ON(13)
    if (IN(PH_N2)) { phase_norm<1>(p, zb, z1, p.norm_w + 3 * DM, bufa, (float*)(ws + WS_RS5)); SEAM(PH_N2); }
#endif
#if ON(14)
    if (IN(PH_GGU)) { pg8::Gemm g5{bufa, (const bf16_t*)(ws + WS_WGU), T_TOK, 2 * DFF, 1024}; pg8::StaticOrder S; S.init(T_TOK, 2 * DFF, G, c);
        EpiGU E{zb, (const float*)(ws + WS_RS5)}; REPS(PH_GGU) { GEMM_PHASE(EpiGU, g5, S, E); __syncthreads(); } GSEAM(PH_GGU); }
#endif
#if ON(15)
    if (IN(PH_GDN)) { REPS(PH_GDN) PLAIN((pg8::Gemm{zb, (const bf16_t*)(ws + WS_WDN), T_TOK, 1024, DFF}), (EpiPlain{(bf16_t*)(ws + WS_FF), 1024, 1.0f})); GSEAM(PH_GDN); }
#endif
#if ON(16)
    if (IN(PH_N3)) { phase_norm<2>(p, (const bf16_t*)(ws + WS_FF), bufa, p.norm_w + 6 * DM, nullptr, nullptr); }
#endif
#ifdef CUT
    if (p.lo == 100) {
        const size_t gt = (size_t)blockIdx.x * 512 + threadIdx.x, gs = (size_t)gridDim.x * 512, NO = (size_t)T_TOK * 1024;
        for (size_t i = gt; i < NO; i += gs) { float v = 0.f;
            if (CUT == 4) { const bf16_t* z = zb; v = lo_bf(z[3 * i]) + 2.f * lo_bf(z[3 * i + 1]) + 3.f * lo_bf(z[3 * i + 2]);
                if (i < (size_t)NMEMROWS * 1024) v += lo_bf(((const bf16_t*)(ws + WS_KX))[i]) + 5.f * lo_bf(((const bf16_t*)(ws + WS_VXT))[i]); }
            else if (CUT == 5 || CUT == 6) {
#if defined(DIG_A)
                v = lo_bf(((const bf16_t*)(ws + WS_Z + 3 * HSZ))[i]);
#elif defined(DIG_B)
                v = ((i & 1023) >= 512) ? lo_bf(bufa[i]) : 0.f;
#else
                v = lo_bf(bufa[i]) * (float)((i & 1023) >= 512) + lo_bf(((const bf16_t*)p.out)[i]);
#endif
            }
            else if (CUT == 6) { v = lo_bf(((const bf16_t*)p.out)[i]); }
            else v = lo_bf(bufa[i]);
            p.out[i] = v; }
    }
    if (false) {
        const size_t gt = (size_t)blockIdx.x * 512 + threadIdx.x, gs = (size_t)gridDim.x * 512, NO = (size_t)T_TOK * 1024;
        for (size_t i = gt; i < NO; i += gs) p.out[i] = ((const float*)(ws + WS_Z))[i];
    }
#endif
}

extern "C" void kernel_launch(void* const* d_in, const int* in_sizes, int n_in, void* d_out, int out_size, void* d_ws, size_t ws_size, hipStream_t stream) {
    static int grid_blocks = 0;
    if (!grid_blocks) {
        int dev = 0, cus = 0, per_cu = 0;
        hipGetDevice(&dev);
        hipDeviceGetAttribute(&cus, hipDeviceAttributeMultiprocessorCount, dev);
        hipFuncSetAttribute((const void*)fwd_megakernel, hipFuncAttributeMaxDynamicSharedMemorySize, LDS_BYTES);
        hipOccupancyMaxActiveBlocksPerMultiprocessor(&per_cu, (const void*)fwd_megakernel, 512, LDS_BYTES);
        if (per_cu < 1) { fprintf(stderr, "occupancy query says %d blocks/CU\n", per_cu); per_cu = 1; }
        (void)hipGetLastError();
        grid_blocks = cus;
        if (ws_size < WS_END) fprintf(stderr, "workspace too small: %zu < %zu\n", ws_size, (size_t)WS_END);
    }
    if (ws_size < WS_END) return;
    Params p{};
    p.x_p = (const float*)d_in[0]; p.x_s = (const float*)d_in[1]; p.mem_p = (const float*)d_in[2]; p.mem_s = (const float*)d_in[3]; p.norm_w = (const float*)d_in[4];
    p.w_in = (const float*)d_in[5]; p.lg = (const float*)d_in[6]; p.gn_w = (const float*)d_in[7]; p.sgu_nw = (const float*)d_in[8]; p.sgu_w = (const float*)d_in[9];
    p.sgu_b = (const float*)d_in[10]; p.w_out = (const float*)d_in[11]; p.wq = (const float*)d_in[12]; p.wkv = (const float*)d_in[13]; p.wo = (const float*)d_in[14];
    p.wgu = (const float*)d_in[15]; p.wdn = (const float*)d_in[16];
    p.out = (float*)d_out; p.ws = (unsigned char*)d_ws;
#ifndef N_SPLIT
#define N_SPLIT 0
#endif
    if (N_SPLIT) {
#ifdef CUT
        const int nph = CUT + 1, nextra = 2;
#else
        const int nph = PH_COUNT, nextra = 0;
#endif
        for (int ph = 0; ph < nph + nextra; ++ph) { if (ph >= nph) { p.lo = 100 + (ph - nph); p.hi = p.lo; } else { p.lo = ph; p.hi = ph + 1; }
            void* args[] = {&p};
            hipError_t e = hipLaunchCooperativeKernel((const void*)fwd_megakernel, dim3(grid_blocks), dim3(512), args, LDS_BYTES, stream);
            if (e != hipSuccess) fprintf(stderr, "cooperative launch failed: %s (grid %d)\n", hipGetErrorString(e), grid_blocks); }
        return;
    }
    (void)hipMemsetAsync((unsigned char*)d_ws + WS_BAR, 0, 32768, stream);
    p.lo = 0; p.hi = PH_COUNT;
    void* args[] = {&p};
    hipError_t e = hipLaunchCooperativeKernel((const void*)fwd_megakernel, dim3(grid_blocks), dim3(512), args, LDS_BYTES, stream);
    if (e != hipSuccess) fprintf(stderr, "cooperative launch failed: %s (grid %d)\n", hipGetErrorString(e), grid_blocks);
}
```

```cpp
#include <hip/hip_runtime.h>
#include <hip/hip_cooperative_groups.h>
#include <cstdio>
#define PG8_V2 1
namespace pg8 {
#define PG8_LAS __attribute__((address_space(3)))
typedef unsigned short bf16_t;
typedef short bf16x8 __attribute__((ext_vector_type(8)));
typedef float f32x4 __attribute__((ext_vector_type(4)));
typedef unsigned u32x4 __attribute__((ext_vector_type(4)));
constexpr int BM = 256, BK = 64, HALF = 128, HTB = HALF * BK * 2  , STAGE_BYTES = 8 * HTB, NXCD = 8, WGM = 8;

__host__ __device__ __forceinline__ int lds_byte(int r, int c) { const int st = (r >> 4) * 2 + (c >> 5), rr = r & 15, cc = c & 31, ob = rr * 64 + cc * 2; return st * 1024 + (ob ^ (((ob >> 9) & 1) << 5)); }
__host__ __device__ __forceinline__ void stage_rc(int b, int& R, int& C) { const int st = b / 1024, sb = b % 1024, swz = sb ^ (((sb >> 9) & 1) << 5); R = (st >> 1) * 16 + swz / 64; C = (st & 1) * 32 + (swz % 64) / 2; }
__host__ __device__ __forceinline__ int perm32(int rho) { const int n = rho >> 4, i = rho & 15; return 8 * (i >> 2) + 4 * n + (i & 3); }

struct Unit { int pm, pn; };
struct Gemm { const bf16_t* A; const bf16_t* Bt; int M, N, K; };

struct StaticOrder {
    int nM, nN, nwg, G, c;
    __host__ __device__ void init(int M, int N, int G_, int c_) { nM = M / BM; nN = N / BM; nwg = nM * nN; G = G_; c = c_; }
    __host__ __device__ bool next(int i, Unit& u) const {
        const long L = (long)i * G + c; if (L >= nwg) return false;
        int wgid = (int)L; { const int q = nwg / NXCD, r = nwg % NXCD, xcd = wgid % NXCD, off = wgid / NXCD; wgid = (xcd < r ? xcd * (q + 1) : r * (q + 1) + (xcd - r) * q) + off; }
        const int nig = WGM * nN, gid = wgid / nig, fm = gid * WGM, gsz = (nM - fm) < WGM ? (nM - fm) : WGM;
        u.pm = fm + ((wgid % nig) % gsz); u.pn = (wgid % nig) / gsz; return true;
    }
    __device__ __forceinline__ void a_ready(const Unit&) const {}
    __device__ __forceinline__ void done(const Unit&) const {}
};
typedef float f32x2_cv __attribute__((ext_vector_type(2))); typedef __bf16 bf16x2_cv __attribute__((ext_vector_type(2)));
__device__ __forceinline__ unsigned cvt_pk_bf16(float lo, float hi) { const f32x2_cv v = {lo, hi}; return __builtin_bit_cast(unsigned, __builtin_convertvector(v, bf16x2_cv)); }
template <class Epi, class Sched, bool ALIGN_EPI = false, bool SP2 = false>
__device__ __forceinline__ void gemm_phase(PG8_LAS unsigned char* lds, const Gemm g, const Sched& S, const Epi& E) {
    int tid_l = threadIdx.x; asm volatile("" : "+v"(tid_l));
    const int tid = tid_l, wid = __builtin_amdgcn_readfirstlane(tid >> 6), lane = tid & 63, wr = wid >> 2, wc = wid & 3, fr = lane & 15, fq = lane >> 4;
    const int K = g.K, nt = K / BK;
    unsigned voffA[2], voffB[2];
#pragma unroll
    for (int i = 0; i < 2; ++i) { int R, C; stage_rc(tid * 16 + i * 8192, R, C); const int Rb = Epi::PERM ? ((R & ~31) + perm32(R & 31)) : R;
        voffA[i] = (unsigned)(R * K + C) * 2u; voffB[i] = (unsigned)(Rb * K + C) * 2u; }
    const size_t kstep = (size_t)(BK * 2);
    const size_t hstep = (size_t)HALF * K * 2;
    const size_t tstep = 2 * hstep;
    const unsigned ldsw = (unsigned)wid * 1024u;
    const int aoff = lds_byte(wr * 64 + fr, fq * 8), boff = lds_byte(wc * 32 + fr, fq * 8);
#define PG8_SA(b, h) (((b) * 2 + (h)) * HTB)
#define PG8_SB(b, h) ((4 + (b) * 2 + (h)) * HTB)
#define PG8_STAGE(bufoff, gbase, voff) do { _Pragma("unroll") for (int _i = 0; _i < 2; ++_i) \
        __builtin_amdgcn_global_load_lds((const unsigned*)((const char*)(gbase) + (voff)[_i]), (PG8_LAS unsigned*)(lds + (bufoff) + ldsw + _i * 8192), 16, 0, 0); } while (0)
#define PG8_LDA(dst, b, h) do { _Pragma("unroll") for (int m = 0; m < 4; ++m) _Pragma("unroll") for (int k = 0; k < 2; ++k) dst[m][k] = *(const PG8_LAS bf16x8*)(lds + PG8_SA(b, h) + aoff + m * 2048 + k * 1024); } while (0)
#define PG8_LDB(dst, b, h) do { _Pragma("unroll") for (int n = 0; n < 2; ++n) _Pragma("unroll") for (int k = 0; k < 2; ++k) dst[n][k] = *(const PG8_LAS bf16x8*)(lds + PG8_SB(b, h) + boff + n * 2048 + k * 1024); } while (0)
#define PG8_MMA(ai, bj, At, Bt) do { __builtin_amdgcn_s_setprio(1); _Pragma("unroll") for (int m = 0; m < 4; ++m) _Pragma("unroll") for (int n = 0; n < 2; ++n) _Pragma("unroll") for (int k = 0; k < 2; ++k) \
        acc[ai][bj][m][n] = __builtin_amdgcn_mfma_f32_16x16x32_bf16(Bt[n][k], At[m][k], acc[ai][bj][m][n], 0, 0, 0); __builtin_amdgcn_s_setprio(0); } while (0)
#define PG8_WAIT_V(n) asm volatile("s_waitcnt vmcnt(" #n ")" ::: "memory")
#define PG8_WAIT_L(n) asm volatile("s_waitcnt lgkmcnt(" #n ")" ::: "memory")
#define PG8_BAR __builtin_amdgcn_s_barrier()
#define PG8_SCHED __builtin_amdgcn_sched_barrier(0)
    Unit cur, nxt; int ui = 0;
    if (!S.next(0, cur)) return;
    f32x4 acc[2][2][4][2];
#pragma unroll
    for (int a = 0; a < 2; ++a)
#pragma unroll
        for (int b = 0; b < 2; ++b)
#pragma unroll
            for (int m = 0; m < 4; ++m)
#pragma unroll
                for (int n = 0; n < 2; ++n) acc[a][b][m][n] = (f32x4){0.f, 0.f, 0.f, 0.f};
    bf16x8 At[4][2], B0[2][2], B1[2][2];
    const char* cA = (const char*)g.A + (size_t)cur.pm * tstep; const char* cB = (const char*)g.Bt + (size_t)cur.pn * tstep;
    S.a_ready(cur);
    if constexpr (SP2) {
        PG8_STAGE(PG8_SB(0, 0), cB, voffB); PG8_STAGE(PG8_SB(0, 1), cB + hstep, voffB); PG8_STAGE(PG8_SA(0, 0), cA, voffA); PG8_STAGE(PG8_SA(0, 1), cA + hstep, voffA);
        if (wr == 1) PG8_BAR;
        PG8_WAIT_V(2); PG8_BAR;
        PG8_STAGE(PG8_SB(1, 0), cB + kstep, voffB); PG8_STAGE(PG8_SA(1, 0), cA + kstep, voffA); PG8_STAGE(PG8_SB(1, 1), cB + hstep + kstep, voffB);
        PG8_WAIT_V(6); PG8_BAR;
    } else {
        PG8_STAGE(PG8_SB(0, 0), cB, voffB); PG8_STAGE(PG8_SA(0, 0), cA, voffA); PG8_STAGE(PG8_SB(0, 1), cB + hstep, voffB); PG8_STAGE(PG8_SA(0, 1), cA + hstep, voffA);
        if (wr == 1) PG8_BAR;
        PG8_WAIT_V(4); PG8_BAR;
        PG8_STAGE(PG8_SB(1, 0), cB + kstep, voffB); PG8_STAGE(PG8_SA(1, 0), cA + kstep, voffA); PG8_STAGE(PG8_SB(1, 1), cB + hstep + kstep, voffB);
        PG8_WAIT_V(6); PG8_BAR;
    }
    for (;;) {
        const bool has_next = S.next(ui + 1, nxt);
        const char* nA = has_next ? (const char*)g.A + (size_t)nxt.pm * tstep : cA; const char* nB = has_next ? (const char*)g.Bt + (size_t)nxt.pn * tstep : cB;
        for (int t = 0; t < nt; t += 2) {
            const bool last = (t == nt - 2);
            const char* a1 = cA + (size_t)(t + 1) * kstep;
            const char* a2 = last ? nA : cA + (size_t)(t + 2) * kstep; const char* b2 = last ? nB : cB + (size_t)(t + 2) * kstep;
            const char* a3 = a2 + kstep; const char* b3 = b2 + kstep;
            if (last && has_next) S.a_ready(nxt);
            if constexpr (SP2) {
            PG8_LDB(B0, 0, 0); PG8_LDB(B1, 0, 1); PG8_SCHED; PG8_LDA(At, 0, 0); PG8_STAGE(PG8_SA(1, 1), a1 + hstep, voffA);
            PG8_WAIT_V(8); PG8_WAIT_L(0); PG8_BAR; PG8_MMA(0, 0, At, B0); PG8_MMA(0, 1, At, B1); PG8_BAR; PG8_SCHED;
            PG8_LDA(At, 0, 1); PG8_STAGE(PG8_SB(0, 0), b2, voffB); PG8_STAGE(PG8_SB(0, 1), b2 + hstep, voffB); PG8_STAGE(PG8_SA(0, 0), a2, voffA);
            PG8_WAIT_V(8); PG8_WAIT_L(0); PG8_BAR; PG8_MMA(1, 0, At, B0); PG8_MMA(1, 1, At, B1); PG8_BAR; PG8_SCHED;
            PG8_LDB(B0, 1, 0); PG8_LDB(B1, 1, 1); PG8_SCHED; PG8_LDA(At, 1, 0); PG8_STAGE(PG8_SA(0, 1), a2 + hstep, voffA);
            PG8_WAIT_V(8); PG8_WAIT_L(0); PG8_BAR; PG8_MMA(0, 0, At, B0); PG8_MMA(0, 1, At, B1); PG8_BAR; PG8_SCHED;
            PG8_LDA(At, 1, 1); PG8_STAGE(PG8_SB(1, 0), b3, voffB); PG8_STAGE(PG8_SB(1, 1), b3 + hstep, voffB); PG8_STAGE(PG8_SA(1, 0), a3, voffA);
            PG8_WAIT_V(8); PG8_WAIT_L(0); PG8_BAR; PG8_MMA(1, 0, At, B0); PG8_MMA(1, 1, At, B1); PG8_BAR; PG8_SCHED;
            } else {
            PG8_LDB(B0, 0, 0); PG8_SCHED; PG8_LDA(At, 0, 0); PG8_STAGE(PG8_SA(1, 1), a1 + hstep, voffA);
            PG8_WAIT_L(8); PG8_BAR; PG8_WAIT_L(0); PG8_MMA(0, 0, At, B0); PG8_BAR; PG8_SCHED;
            PG8_LDB(B1, 0, 1); PG8_STAGE(PG8_SB(0, 0), b2, voffB);
            PG8_BAR; PG8_WAIT_L(0); PG8_MMA(0, 1, At, B1); PG8_BAR;
            PG8_LDA(At, 0, 1); PG8_STAGE(PG8_SA(0, 0), a2, voffA);
            PG8_BAR; PG8_WAIT_L(0); PG8_MMA(1, 0, At, B0); PG8_BAR; PG8_SCHED;
            PG8_STAGE(PG8_SB(0, 1), b2 + hstep, voffB);
            PG8_WAIT_V(6); PG8_BAR; PG8_MMA(1, 1, At, B1); PG8_BAR;
            PG8_LDB(B0, 1, 0); PG8_SCHED; PG8_LDA(At, 1, 0); PG8_STAGE(PG8_SA(0, 1), a2 + hstep, voffA);
            PG8_WAIT_L(8); PG8_BAR; PG8_WAIT_L(0); PG8_MMA(0, 0, At, B0); PG8_BAR; PG8_SCHED;
            PG8_LDB(B1, 1, 1); PG8_STAGE(PG8_SB(1, 0), b3, voffB);
            PG8_BAR; PG8_WAIT_L(0); PG8_MMA(0, 1, At, B1); PG8_BAR;
            PG8_LDA(At, 1, 1); PG8_STAGE(PG8_SA(1, 0), a3, voffA);
            PG8_BAR; PG8_WAIT_L(0); PG8_MMA(1, 0, At, B0); PG8_BAR; PG8_SCHED;
            PG8_STAGE(PG8_SB(1, 1), b3 + hstep, voffB);
            PG8_WAIT_V(6); PG8_BAR; PG8_MMA(1, 1, At, B1); PG8_BAR;
            }
        }
        if constexpr (ALIGN_EPI) { if (wr == 0) PG8_BAR; }
        if constexpr (!Epi::AFTER_DRAIN) { E(acc, cur, wr, wc, fr, fq); S.done(cur); }
        if (!has_next) break;
#pragma unroll
        for (int a = 0; a < 2; ++a)
#pragma unroll
            for (int b = 0; b < 2; ++b)
#pragma unroll
                for (int m = 0; m < 4; ++m)
#pragma unroll
                    for (int n = 0; n < 2; ++n) acc[a][b][m][n] = (f32x4){0.f, 0.f, 0.f, 0.f};
        cur = nxt; cA = nA; cB = nB; ++ui;
        if constexpr (ALIGN_EPI) { if (wr == 1) PG8_BAR; }
    }
    PG8_WAIT_V(0);
    if constexpr (!ALIGN_EPI) { if (wr == 0) PG8_BAR; }
    PG8_BAR;
    if constexpr (Epi::AFTER_DRAIN) { E.fused(acc, cur, wr, wc, fr, fq, lds, wid, lane); S.done(cur); }
#undef PG8_SA
#undef PG8_SB
#undef PG8_STAGE
#undef PG8_LDA
#undef PG8_LDB
#undef PG8_MMA
#undef PG8_WAIT_V
#undef PG8_WAIT_L
#undef PG8_BAR
#undef PG8_SCHED
}
}

namespace cg = cooperative_groups;
using pg8::bf16_t; using pg8::bf16x8; using pg8::f32x4; using pg8::u32x4; using pg8::cvt_pk_bf16;
#define LAS __attribute__((address_space(3)))
typedef unsigned u32x2 __attribute__((ext_vector_type(2)));

constexpr int T_TOK = 98304, T_PROMPT = 65536, DM = 1024, NMEMROWS = 5120, DFF = 2816;
constexpr int NCHUNK = T_TOK / 128;
constexpr float EPSF = 1e-6f;
constexpr int TS = 272;
constexpr int TILEB = 128 * TS;
constexpr int TS2 = 528;
constexpr int XBST_OFF = 4 * TILEB;
constexpr int LDS_BYTES = 4 * TILEB + 16;

constexpr size_t al256(size_t x) { return (x + 255) & ~(size_t)255; }
constexpr size_t WS_WIN = 0;
constexpr size_t WS_WINV = WS_WIN + (size_t)2560 * 1024 * 2;
constexpr size_t WS_WOUT = WS_WINV + (size_t)512 * 1024 * 2;
constexpr size_t WS_WQ = WS_WOUT + (size_t)1024 * 1024 * 2;
constexpr size_t WS_WKV = WS_WQ + (size_t)1024 * 1024 * 2;
constexpr size_t WS_WO = WS_WKV + (size_t)2048 * 1024 * 2;
constexpr size_t WS_WGU = WS_WO + (size_t)1024 * 1024 * 2;
constexpr size_t WS_WDN = WS_WGU + (size_t)5632 * 1024 * 2;
constexpr size_t WS_SGUW = WS_WDN + (size_t)1024 * 2816 * 2;
constexpr size_t WS_COS = WS_SGUW + (size_t)4 * 128 * 128 * 2;
constexpr size_t WS_SIN = WS_COS + (size_t)8192 * 64 * 4;
constexpr size_t WS_MEMN = WS_SIN + (size_t)8192 * 64 * 4;
constexpr size_t WS_KX = WS_MEMN + (size_t)NMEMROWS * 1024 * 2;
constexpr size_t WS_VXT = WS_KX + (size_t)NMEMROWS * 1024 * 2;
constexpr size_t WS_RS2 = al256(WS_VXT + (size_t)NMEMROWS * 1024 * 2);
constexpr size_t WS_RS5 = WS_RS2 + (size_t)98304 * 4;
constexpr size_t WS_BAR = WS_RS5 + (size_t)98304 * 4;
constexpr size_t WS_BUFA = al256(WS_BAR + 16384);
constexpr size_t USZ = (size_t)T_TOK * 1024 * 2;
constexpr size_t HSZ = USZ / 2;
constexpr size_t WS_Z = WS_BUFA + USZ;
constexpr size_t WS_FF = al256(WS_Z + (size_t)98304 * 2816 * 2);
constexpr size_t WS_END = WS_FF + USZ;

struct Params {
    const float* x_p; const float* x_s; const float* mem_p; const float* mem_s; const float* norm_w; const float* w_in; const float* lg; const float* gn_w;
    const float* sgu_nw; const float* sgu_w; const float* sgu_b; const float* w_out; const float* wq; const float* wkv; const float* wo; const float* wgu; const float* wdn;
    float* out; unsigned char* ws; int lo, hi;
};

__device__ __forceinline__ float lo_bf(unsigned w) { return __uint_as_float(w << 16); }
__device__ __forceinline__ float hi_bf(unsigned w) { return __uint_as_float(w & 0xffff0000u); }
__device__ __forceinline__ float fast_exp2(float x) { return __builtin_amdgcn_exp2f(x); }
__device__ __forceinline__ float silu_f(float x) { return x * __builtin_amdgcn_rcpf(1.0f + fast_exp2(-1.4426950408889634f * x)); }
__device__ __forceinline__ float gelu_tanh_f(float x) { const float y = 0.7978845608028654f * (x + 0.044715f * x * x * x); return x * __builtin_amdgcn_rcpf(1.0f + fast_exp2(-2.885390081777927f * y)); }
__device__ __forceinline__ float wave_sum(float v) {
#pragma unroll
    for (int o = 32; o >= 1; o >>= 1) v += __shfl_xor(v, o);
    return v;
}
__device__ __forceinline__ const float* xrow(const Params& p, int t) { return t < T_PROMPT ? p.x_p + (size_t)t * DM : p.x_s + (size_t)(t - T_PROMPT) * DM; }

struct EpiPlain {
    static constexpr bool PERM = true, AFTER_DRAIN = false;
    bf16_t* O; size_t ldc; float scale;
    __device__ __forceinline__ void operator()(const f32x4 (&acc)[2][2][4][2], const pg8::Unit& u, int wr, int wc, int fr_, int fq_) const {
        int t_ = threadIdx.x; asm volatile("" : "+v"(t_)); const int fr = t_ & 15, fq = (t_ >> 4) & 3;
        const int row0 = u.pm * 256 + wr * 64 + fr, col0 = u.pn * 256 + wc * 32 + 8 * fq;
#pragma unroll
        for (int ai = 0; ai < 2; ++ai)
#pragma unroll
            for (int m = 0; m < 4; ++m) { bf16_t* rowp = O + (size_t)(row0 + ai * 128 + m * 16) * ldc + col0;
#pragma unroll
                for (int bj = 0; bj < 2; ++bj) { const f32x4 v0 = acc[ai][bj][m][0] * scale, v1 = acc[ai][bj][m][1] * scale;
                    u32x4 w; w.x = cvt_pk_bf16(v0[0], v0[1]); w.y = cvt_pk_bf16(v0[2], v0[3]); w.z = cvt_pk_bf16(v1[0], v1[1]); w.w = cvt_pk_bf16(v1[2], v1[3]);
                    *(u32x4*)(rowp + bj * 128) = w; } }
    }
};
struct EpiG1A {
    static constexpr bool PERM = true, AFTER_DRAIN = false;
    bf16_t* zb; const float* cosT; const float* sinT;
    __device__ __forceinline__ void operator()(const f32x4 (&acc)[2][2][4][2], const pg8::Unit& u, int wr, int wc, int fr_, int fq_) const {
        int t_ = threadIdx.x; asm volatile("" : "+v"(t_));
        const int fr = t_ & 15, fq = (t_ >> 4) & 3;
        const int part = u.pn >> 1, half = u.pn & 1;
        const int row0 = u.pm * 256 + wr * 64 + fr, cb = half * 256 + wc * 32 + 8 * fq;
        bf16_t* O = zb + (size_t)part * ((size_t)T_TOK * 512);
        if (part < 2) {
            const int j0 = 16 * wc + 4 * fq;
#pragma unroll
            for (int ai = 0; ai < 2; ++ai)
#pragma unroll
                for (int m = 0; m < 4; ++m) { const int row = row0 + ai * 128 + m * 16; const int pos = row & (row < T_PROMPT ? 4095 : 8191);
                    const f32x4 c4 = *(const f32x4*)(cosT + pos * 64 + j0), s4 = *(const f32x4*)(sinT + pos * 64 + j0);
#pragma unroll
                    for (int bj = 0; bj < 2; ++bj) { const f32x4 v0 = acc[ai][bj][m][0], v1 = acc[ai][bj][m][1];
                        const f32x4 o1 = v0 * c4 - v1 * s4, o2 = v0 * s4 + v1 * c4;
                        u32x4 w; w.x = cvt_pk_bf16(o1[0], o1[1]); w.y = cvt_pk_bf16(o1[2], o1[3]); w.z = cvt_pk_bf16(o2[0], o2[1]); w.w = cvt_pk_bf16(o2[2], o2[3]);
                        *(u32x4*)(O + (size_t)row * 512 + cb + bj * 128) = w; }
                    if (m == 3) asm volatile("" ::: "memory"); }
        } else {
#pragma unroll
            for (int ai = 0; ai < 2; ++ai)
#pragma unroll
                for (int m = 0; m < 4; ++m) { const int row = row0 + ai * 128 + m * 16;
#pragma unroll
                    for (int bj = 0; bj < 2; ++bj) { f32x4 v0 = acc[ai][bj][m][0], v1 = acc[ai][bj][m][1];
                        if (part == 2) {
#pragma unroll
                            for (int j = 0; j < 4; ++j) { v0[j] = silu_f(v0[j]); v1[j] = silu_f(v1[j]); }
                        } else {
#pragma unroll
                            for (int j = 0; j < 4; ++j) { v0[j] = gelu_tanh_f(v0[j]); v1[j] = gelu_tanh_f(v1[j]); }
                        }
                        u32x4 w; w.x = cvt_pk_bf16(v0[0], v0[1]); w.y = cvt_pk_bf16(v0[2], v0[3]); w.z = cvt_pk_bf16(v1[0], v1[1]); w.w = cvt_pk_bf16(v1[2], v1[3]);
                        *(u32x4*)(O + (size_t)row * 512 + cb + bj * 128) = w; } }
        }
    }
};
struct EpiPlainRS {
    static constexpr bool PERM = true, AFTER_DRAIN = false;
    bf16_t* O; size_t ldc; float scale; const float* rs;
    __device__ __forceinline__ void operator()(const f32x4 (&acc)[2][2][4][2], const pg8::Unit& u, int wr, int wc, int fr_, int fq_) const {
        int t_ = threadIdx.x; asm volatile("" : "+v"(t_)); const int fr = t_ & 15, fq = (t_ >> 4) & 3;
        const int row0 = u.pm * 256 + wr * 64 + fr, col0 = u.pn * 256 + wc * 32 + 8 * fq;
#pragma unroll
        for (int ai = 0; ai < 2; ++ai)
#pragma unroll
            for (int m = 0; m < 4; ++m) { const int row = row0 + ai * 128 + m * 16; const float r = rs[row] * scale; bf16_t* rowp = O + (size_t)row * ldc + col0;
#pragma unroll
                for (int bj = 0; bj < 2; ++bj) { const f32x4 v0 = acc[ai][bj][m][0] * r, v1 = acc[ai][bj][m][1] * r;
                    u32x4 w; w.x = cvt_pk_bf16(v0[0], v0[1]); w.y = cvt_pk_bf16(v0[2], v0[3]); w.z = cvt_pk_bf16(v1[0], v1[1]); w.w = cvt_pk_bf16(v1[2], v1[3]);
                    *(u32x4*)(rowp + bj * 128) = w; } }
    }
};
struct EpiGU {
    static constexpr bool PERM = true, AFTER_DRAIN = false;
    bf16_t* O; const float* rs;
    __device__ __forceinline__ void operator()(const f32x4 (&acc)[2][2][4][2], const pg8::Unit& u, int wr, int wc, int fr_, int fq_) const {
        int t_ = threadIdx.x; asm volatile("" : "+v"(t_)); const int fr = t_ & 15, fq = (t_ >> 4) & 3;
        const int row0 = u.pm * 256 + wr * 64 + fr, col0 = u.pn * 128 + wc * 32 + 8 * fq;
#pragma unroll
        for (int ai = 0; ai < 2; ++ai)
#pragma unroll
            for (int m = 0; m < 4; ++m) { const float r = rs[row0 + ai * 128 + m * 16]; const f32x4 g0 = acc[ai][0][m][0] * r, g1 = acc[ai][0][m][1] * r, u0 = acc[ai][1][m][0] * r, u1 = acc[ai][1][m][1] * r; f32x4 o0, o1;
#pragma unroll
                for (int j = 0; j < 4; ++j) { o0[j] = silu_f(g0[j]) * u0[j]; o1[j] = silu_f(g1[j]) * u1[j]; }
                u32x4 w; w.x = cvt_pk_bf16(o0[0], o0[1]); w.y = cvt_pk_bf16(o0[2], o0[3]); w.z = cvt_pk_bf16(o1[0], o1[1]); w.w = cvt_pk_bf16(o1[2], o1[3]);
                *(u32x4*)(O + (size_t)(row0 + ai * 128 + m * 16) * DFF + col0) = w; }
    }
};

__device__ __forceinline__ f32x4 zero_acc() { f32x4 a = {0.f, 0.f, 0.f, 0.f}; asm volatile("" : "+v"(a)); return a; }
template <int NI, int KS> __device__ __forceinline__ void mm_ra(f32x4 (&acc)[NI], const bf16x8 (&a)[KS], const LAS unsigned char* B, int ldb, int fr, int fq) {
#pragma unroll
    for (int ks = 0; ks < KS; ++ks)
#pragma unroll
        for (int ni = 0; ni < NI; ++ni) { const bf16x8 b = *(const LAS bf16x8*)(B + (16 * ni + fr) * ldb + (32 * ks + 8 * fq) * 2);
            acc[ni] = __builtin_amdgcn_mfma_f32_16x16x32_bf16(b, a[ks], acc[ni], 0, 0, 0); }
}
template <int KS> __device__ __forceinline__ void ld_afrag_lds(bf16x8 (&a)[KS], const LAS unsigned char* A, int lda, int fr, int fq) {
#pragma unroll
    for (int ks = 0; ks < KS; ++ks) a[ks] = *(const LAS bf16x8*)(A + fr * lda + (32 * ks + 8 * fq) * 2);
}

__device__ __forceinline__ int rotmap(int r) { return 64 * ((r >> 2) & 1) + 16 * (r >> 5) + 4 * ((r >> 3) & 3) + (r & 3); }
__device__ __forceinline__ int win_main_col(int s) {
    const int part = s >> 9, c = s & 511;
    if (part < 2) return part * 512 + (c & ~127) + rotmap(c & 127);
    return (part + 1) * 512 + c;
}
template <int JOB> __device__ __forceinline__ void wtile_load(float (&v)[8], const float* W, int ldw, int k0, int s0, const float* ksc, int tid) {
#pragma unroll
    for (int it = 0; it < 8; ++it) { const int idx = tid + 512 * it, kk = idx >> 6, ss = idx & 63, s = s0 + ss; int col;
        if (JOB == 0) col = win_main_col(s);
        else if (JOB == 1) col = 1024 + s;
        else if (JOB == 2) { const int pn = s >> 8, r = s & 255; col = (r >> 7) * DFF + 128 * pn + (r & 127); }
        else col = s;
        float wv = W[(size_t)(k0 + kk) * ldw + col]; if (JOB == 0 && (s >> 9) == 1) wv *= 0.08838834764831845f;
        if (ksc) wv *= ksc[k0 + kk];
        v[it] = wv; }
}
template <int JOB> __device__ __forceinline__ void wjob(LAS float* tl, const float* W, int ldw, bf16_t* Bt, int K, int nslots, int& base, const float* ksc = nullptr) {
    int tid_l = threadIdx.x; asm volatile("" : "+v"(tid_l)); const int tid = tid_l;
    const int nkt = K / 64, nst = nslots / 64, ntile = nkt * nst;
    int first = (int)blockIdx.x - (base % (int)gridDim.x); if (first < 0) first += gridDim.x;
    float v[8];
    if (first < ntile) wtile_load<JOB>(v, W, ldw, (first % nkt) * 64, (first / nkt) * 64, ksc, tid);
    for (int t = first; t < ntile; t += gridDim.x) {
        const int k0 = (t % nkt) * 64, s0 = (t / nkt) * 64;
#pragma unroll
        for (int it = 0; it < 8; ++it) { const int idx = tid + 512 * it; tl[(idx >> 6) * 65 + (idx & 63)] = v[it]; }
        __syncthreads();
        const int tn = t + (int)gridDim.x;
        if (tn < ntile) wtile_load<JOB>(v, W, ldw, (tn % nkt) * 64, (tn / nkt) * 64, ksc, tid);
        { const int ss = tid >> 3, kg = tid & 7; float x[8];
#pragma unroll
          for (int q = 0; q < 8; ++q) x[q] = tl[(8 * kg + q) * 65 + ss];
          u32x4 w; w.x = cvt_pk_bf16(x[0], x[1]); w.y = cvt_pk_bf16(x[2], x[3]); w.z = cvt_pk_bf16(x[4], x[5]); w.w = cvt_pk_bf16(x[6], x[7]);
          *(u32x4*)(Bt + (size_t)(s0 + ss) * K + k0 + 8 * kg) = w; }
        __syncthreads();
    }
    base += ntile;
}
__device__ __forceinline__ void rms_row_to_bf16(const float* src, const float* w, bf16_t* dst, int lane) {
    f32x4 v[4]; float ss = 0.f;
#pragma unroll
    for (int i = 0; i < 4; ++i) { v[i] = *(const f32x4*)(src + lane * 4 + 256 * i); ss += v[i][0] * v[i][0] + v[i][1] * v[i][1] + v[i][2] * v[i][2] + v[i][3] * v[i][3]; }
    ss = wave_sum(ss);
    const float r = 1.0f / sqrtf(ss * (1.0f / 1024.0f) + EPSF);
#pragma unroll
    for (int i = 0; i < 4; ++i) { const f32x4 wv = *(const f32x4*)(w + lane * 4 + 256 * i); const f32x4 o = v[i] * r * wv;
        u32x2 pk; pk.x = cvt_pk_bf16(o[0], o[1]); pk.y = cvt_pk_bf16(o[2], o[3]); *(u32x2*)(dst + lane * 4 + 256 * i) = pk; }
}
__device__ __forceinline__ void phase_prep(const Params& p, LAS unsigned char* lds) {
    unsigned char* ws = p.ws; LAS float* tl = (LAS float*)lds;
    int base = 0;
    wjob<0>(tl, p.w_in, 3072, (bf16_t*)(ws + WS_WIN), 1024, 2560, base);
    wjob<1>(tl, p.w_in, 3072, (bf16_t*)(ws + WS_WINV), 1024, 512, base);
    wjob<3>(tl, p.w_out, 1024, (bf16_t*)(ws + WS_WOUT), 1024, 1024, base);
    wjob<3>(tl, p.wq, 1024, (bf16_t*)(ws + WS_WQ), 1024, 1024, base, p.norm_w + 2 * DM);
    wjob<3>(tl, p.wkv, 2048, (bf16_t*)(ws + WS_WKV), 1024, 2048, base);
    wjob<3>(tl, p.wo, 1024, (bf16_t*)(ws + WS_WO), 1024, 1024, base);
    wjob<2>(tl, p.wgu, 2 * DFF, (bf16_t*)(ws + WS_WGU), 1024, 2 * DFF, base, p.norm_w + 5 * DM);
    wjob<3>(tl, p.wdn, 1024, (bf16_t*)(ws + WS_WDN), DFF, 1024, base);
    const int gtid = blockIdx.x * 512 + threadIdx.x, gsz = gridDim.x * 512;
    { bf16_t* o = (bf16_t*)(ws + WS_SGUW); for (int i = gtid; i < 4 * 128 * 128 / 2; i += gsz) { const float a = p.sgu_w[2 * i], b = p.sgu_w[2 * i + 1]; ((unsigned*)o)[i] = cvt_pk_bf16(a, b); } }
    { float* ct = (float*)(ws + WS_COS); float* st = (float*)(ws + WS_SIN);
      for (int i = gtid; i < 8192 * 64; i += gsz) { const int pos = i >> 6, j = i & 63;
          const float inv = exp2f(-(float)j * (13.287712379549449f / 64.0f));
          const float ang = (float)pos * inv;
          const double rev = (double)ang * 0.15915494309189535; const float fr_ = (float)(rev - rint(rev));
          ct[i] = __builtin_amdgcn_cosf(fr_); st[i] = __builtin_amdgcn_sinf(fr_); } }
    { const int wid = threadIdx.x >> 6, lane = threadIdx.x & 63; const int gw = blockIdx.x * 8 + wid, nw = gridDim.x * 8;
      bf16_t* hb = (bf16_t*)(ws + WS_BUFA); bf16_t* mn = (bf16_t*)(ws + WS_MEMN);
      for (int r0 = 4 * gw; r0 < T_TOK + NMEMROWS; r0 += 4 * nw) {
          const float* src[4]; const float* wn; bf16_t* dst[4];
#pragma unroll
          for (int k = 0; k < 4; ++k) { const int r = r0 + k;
              if (r < T_TOK) { src[k] = xrow(p, r); dst[k] = hb + (size_t)r * DM; }
              else { const int m = r - T_TOK; src[k] = m < 4096 ? p.mem_p + (size_t)m * DM : p.mem_s + (size_t)(m - 4096) * DM; dst[k] = mn + (size_t)m * DM; } }
          wn = r0 < T_TOK ? p.norm_w + 0 * DM : p.norm_w + 4 * DM;
          f32x4 v[4][4]; float ss[4];
#pragma unroll
          for (int k = 0; k < 4; ++k)
#pragma unroll
              for (int i = 0; i < 4; ++i) v[k][i] = *(const f32x4*)(src[k] + lane * 4 + 256 * i);
#pragma unroll
          for (int k = 0; k < 4; ++k) { ss[k] = 0.f;
#pragma unroll
              for (int i = 0; i < 4; ++i) ss[k] += v[k][i][0] * v[k][i][0] + v[k][i][1] * v[k][i][1] + v[k][i][2] * v[k][i][2] + v[k][i][3] * v[k][i][3];
              ss[k] = wave_sum(ss[k]); }
#pragma unroll
          for (int k = 0; k < 4; ++k) { const float rr = 1.0f / sqrtf(ss[k] * (1.0f / 1024.0f) + EPSF);
#pragma unroll
              for (int i = 0; i < 4; ++i) { const f32x4 wv = *(const f32x4*)(wn + lane * 4 + 256 * i); const f32x4 o = v[k][i] * rr * wv;
                  u32x2 pk; pk.x = cvt_pk_bf16(o[0], o[1]); pk.y = cvt_pk_bf16(o[2], o[3]); *(u32x2*)(dst[k] + lane * 4 + 256 * i) = pk; } } } }
    __syncthreads();
}

__device__ __forceinline__ void phase_r1(const Params& p, LAS unsigned char* lds) {
    int tid_l = threadIdx.x; asm volatile("" : "+v"(tid_l)); const int tid = tid_l, wid = tid >> 6, lane = tid & 63, fr = lane & 15, fq = lane >> 4;
    const bf16_t* kb = (const bf16_t*)(p.ws + WS_Z + 1 * HSZ); const bf16_t* vt = (const bf16_t*)(p.ws + WS_Z + 5 * HSZ);
    bf16_t* wb = (bf16_t*)p.out;
    LAS unsigned char* KfT = lds; LAS unsigned char* KbT = lds + TILEB; LAS unsigned char* VT = lds + 2 * TILEB;
    const int jp = tid & 63;
    const int NU = NCHUNK * 4;
    u32x4 RK[2][2], RV[4];
#define R1_LOAD(uu) do { const int cg_ = (uu) >> 2, h_ = (uu) & 3; const size_t t0_ = (size_t)cg_ * 128; \
        _Pragma("unroll") for (int it = 0; it < 2; ++it) { const int c = (tid >> 6) + 8 * it; \
            RK[it][0] = *(const u32x4*)(kb + (t0_ + 2 * jp) * 512 + h_ * 128 + 8 * c); RK[it][1] = *(const u32x4*)(kb + (t0_ + 2 * jp + 1) * 512 + h_ * 128 + 8 * c); } \
        _Pragma("unroll") for (int it = 0; it < 4; ++it) { const int id = tid + 512 * it, r = id >> 4, c = id & 15; \
            RV[it] = *(const u32x4*)(vt + (size_t)(h_ * 128 + r) * T_TOK + t0_ + 8 * c); } } while (0)
    int u = blockIdx.x;
    if (u < NU) R1_LOAD(u);
    for (; u < NU; u += gridDim.x) {
        const int cgi = u >> 2, h = u & 3;
        const float lf2 = p.lg[h] * 1.4426950408889634f, lb2 = p.lg[4 + h] * 1.4426950408889634f;
        const float ff0 = fast_exp2(lf2 * (float)(127 - 2 * jp)), ff1 = fast_exp2(lf2 * (float)(126 - 2 * jp));
        const float fb0 = fast_exp2(lb2 * (float)(2 * jp)), fb1 = fast_exp2(lb2 * (float)(2 * jp + 1));
#pragma unroll
        for (int it = 0; it < 2; ++it) { const int c = (tid >> 6) + 8 * it; const u32x4 r0 = RK[it][0], r1 = RK[it][1];
#pragma unroll
            for (int q = 0; q < 8; ++q) { const unsigned w0 = r0[q >> 1], w1 = r1[q >> 1];
                const float e0 = (q & 1) ? hi_bf(w0) : lo_bf(w0), e1 = (q & 1) ? hi_bf(w1) : lo_bf(w1);
                *(LAS unsigned*)(KfT + (8 * c + q) * TS + 4 * jp) = cvt_pk_bf16(e0 * ff0, e1 * ff1);
                *(LAS unsigned*)(KbT + (8 * c + q) * TS + 4 * jp) = cvt_pk_bf16(e0 * fb0, e1 * fb1); } }
#pragma unroll
        for (int it = 0; it < 4; ++it) { const int id = tid + 512 * it, r = id >> 4, c = id & 15; *(LAS u32x4*)(VT + r * TS + c * 16) = RV[it]; }
        __syncthreads();
        if (u + (int)gridDim.x < NU) R1_LOAD(u + (int)gridDim.x);
        bf16x8 a[4]; ld_afrag_lds<4>(a, VT + 16 * wid * TS, TS, fr, fq);
#pragma unroll
        for (int dir = 0; dir < 2; ++dir) {
            f32x4 acc[8];
#pragma unroll
            for (int ni = 0; ni < 8; ++ni) acc[ni] = zero_acc();
            mm_ra<8, 4>(acc, a, dir ? KbT : KfT, TS, fr, fq);
            bf16_t* o = wb + ((size_t)(dir * NCHUNK + cgi) * 4 + h) * 16384 + (16 * wid + fr) * 128 + 4 * fq;
#pragma unroll
            for (int ni = 0; ni < 8; ++ni) { u32x2 pk; pk.x = cvt_pk_bf16(acc[ni][0], acc[ni][1]); pk.y = cvt_pk_bf16(acc[ni][2], acc[ni][3]); *(u32x2*)(o + 16 * ni) = pk; }
        }
        __syncthreads();
    }
#undef R1_LOAD
}
__device__ __forceinline__ void phase_sgu(const Params& p, LAS unsigned char* lds) {
    int tid_l = threadIdx.x; asm volatile("" : "+v"(tid_l)); const int tid = tid_l, wid = tid >> 6, lane = tid & 63, fr = lane & 15, fq = lane >> 4;
    const bf16_t* ub = (const bf16_t*)(p.ws + WS_Z + 3 * HSZ); const bf16_t* vsb = (const bf16_t*)(p.ws + WS_Z + 4 * HSZ);
    const bf16_t* sw = (const bf16_t*)(p.ws + WS_SGUW); bf16_t* mixed = (bf16_t*)(p.ws + WS_BUFA);
    LAS unsigned char* VnT = lds; LAS float* stat = (LAS float*)(lds + TILEB);
    const int jp = tid & 63;
    for (int cgi = blockIdx.x; cgi < NCHUNK; cgi += gridDim.x) {
        const size_t t0 = (size_t)cgi * 128;
        u32x4 TR[2][2]; bf16x8 a[4], an[4];
#define SGU_LOADT(g) do { _Pragma("unroll") for (int it = 0; it < 2; ++it) { const int c = (tid >> 6) + 8 * it; \
            TR[it][0] = *(const u32x4*)(vsb + (t0 + 2 * jp) * 512 + (g) * 128 + 8 * c); TR[it][1] = *(const u32x4*)(vsb + (t0 + 2 * jp + 1) * 512 + (g) * 128 + 8 * c); } } while (0)
#define SGU_LOADA(g, AD) do { _Pragma("unroll") for (int ks = 0; ks < 4; ++ks) AD[ks] = *(const bf16x8*)(sw + (size_t)(g) * 16384 + (16 * wid + fr) * 128 + 32 * ks + 8 * fq); } while (0)
        SGU_LOADT(0); SGU_LOADA(0, a);
        { const int q = tid >> 2, part = tid & 3; float sm = 0.f, s2 = 0.f;
#pragma unroll
          for (int c = 0; c < 16; ++c) { const u32x4 r = *(const u32x4*)(vsb + (t0 + q) * 512 + part * 128 + 8 * c);
#pragma unroll
              for (int k = 0; k < 4; ++k) { const float x0 = lo_bf(r[k]), x1 = hi_bf(r[k]); sm += x0 + x1; s2 += x0 * x0 + x1 * x1; } }
          sm += __shfl_xor(sm, 1); sm += __shfl_xor(sm, 2); s2 += __shfl_xor(s2, 1); s2 += __shfl_xor(s2, 2);
          const float mu = sm * (1.0f / 512.0f), var = fmaxf(s2 * (1.0f / 512.0f) - mu * mu, 0.f);
          if (part == 0) { stat[2 * q] = mu; stat[2 * q + 1] = 1.0f / sqrtf(var + EPSF); } }
        __syncthreads();
        const float mu0 = stat[4 * jp], rs0 = stat[4 * jp + 1], mu1 = stat[4 * jp + 2], rs1 = stat[4 * jp + 3];
#pragma unroll
        for (int g = 0; g < 4; ++g) {
#pragma unroll
            for (int it = 0; it < 2; ++it) { const int c = (tid >> 6) + 8 * it; const u32x4 r0 = TR[it][0], r1 = TR[it][1];
                const f32x4 wa = *(const f32x4*)(p.sgu_nw + g * 128 + 8 * c), wb_ = *(const f32x4*)(p.sgu_nw + g * 128 + 8 * c + 4);
#pragma unroll
                for (int q = 0; q < 8; ++q) { const unsigned w0 = r0[q >> 1], w1 = r1[q >> 1]; const float wq_ = q < 4 ? wa[q & 3] : wb_[q & 3];
                    const float e0 = (q & 1) ? hi_bf(w0) : lo_bf(w0), e1 = (q & 1) ? hi_bf(w1) : lo_bf(w1);
                    *(LAS unsigned*)(VnT + (8 * c + q) * TS + 4 * jp) = cvt_pk_bf16((e0 - mu0) * rs0 * wq_, (e1 - mu1) * rs1 * wq_); } }
            __syncthreads();
            if (g < 3) { SGU_LOADT(g + 1); SGU_LOADA(g + 1, an); }
            const int prow = 16 * wid + fr; const float bias = p.sgu_b[g * 128 + prow];
            const bf16_t* up = ub + (t0 + prow) * 512 + g * 128 + 4 * fq; bf16_t* op = mixed + (t0 + prow) * 1024 + 512 + g * 128 + 4 * fq;
            u32x2 UU[8];
#pragma unroll
            for (int ni = 0; ni < 8; ++ni) UU[ni] = *(const u32x2*)(up + 16 * ni);
            f32x4 acc[8];
#pragma unroll
            for (int ni = 0; ni < 8; ++ni) acc[ni] = zero_acc();
            mm_ra<8, 4>(acc, a, VnT, TS, fr, fq);
#pragma unroll
            for (int ni = 0; ni < 8; ++ni) { const u32x2 uu = UU[ni];
                u32x2 pk; pk.x = cvt_pk_bf16((acc[ni][0] + bias) * lo_bf(uu.x), (acc[ni][1] + bias) * hi_bf(uu.x)); pk.y = cvt_pk_bf16((acc[ni][2] + bias) * lo_bf(uu.y), (acc[ni][3] + bias) * hi_bf(uu.y));
                *(u32x2*)(op + 16 * ni) = pk; }
            __syncthreads();
            if (g < 3) {
#pragma unroll
                for (int ks = 0; ks < 4; ++ks) a[ks] = an[ks];
            }
        }
#undef SGU_LOADT
#undef SGU_LOADA
    }
}
__device__ __forceinline__ void phase_scan(const Params& p) {
    const bf16_t* wb = (const bf16_t*)p.out; bf16_t* rb = (bf16_t*)p.out + USZ / 2;
    const int gtid = blockIdx.x * 512 + threadIdx.x, gsz = gridDim.x * 512;
    for (int item = gtid; item < 20 * 4 * 2 * 2048; item += gsz) {
        const int e8 = item & 2047, dir = (item >> 11) & 1, h = (item >> 12) & 3, s = item >> 14;
        const int cg0 = s < 16 ? s * 32 : 512 + (s - 16) * 64, n = s < 16 ? 32 : 64;
        const float dec = fast_exp2(p.lg[dir * 4 + h] * (128.0f * 1.4426950408889634f));
        float st[8];
#pragma unroll
        for (int k = 0; k < 8; ++k) st[k] = 0.f;
        for (int c0 = 0; c0 < n; c0 += 8) {
            u32x4 w[8];
#pragma unroll
            for (int k = 0; k < 8; ++k) { const int c = dir ? (n - 1 - (c0 + k)) : (c0 + k);
                w[k] = *(const u32x4*)(wb + ((size_t)(dir * NCHUNK + cg0 + c) * 4 + h) * 16384 + e8 * 8); }
#pragma unroll
            for (int k = 0; k < 8; ++k) { const int c = dir ? (n - 1 - (c0 + k)) : (c0 + k);
                u32x4 o;
#pragma unroll
                for (int q = 0; q < 4; ++q) { o[q] = cvt_pk_bf16(st[2 * q], st[2 * q + 1]);
                    st[2 * q] = dec * st[2 * q] + lo_bf(w[k][q]); st[2 * q + 1] = dec * st[2 * q + 1] + hi_bf(w[k][q]); }
                *(u32x4*)(rb + ((size_t)(dir * NCHUNK + cg0 + c) * 4 + h) * 16384 + e8 * 8) = o; }
        }
    }
}
__device__ __forceinline__ void phase_r3(const Params& p, LAS unsigned char* lds) {
    int tid_l = threadIdx.x; asm volatile("" : "+v"(tid_l)); const int tid = tid_l, wid = tid >> 6, lane = tid & 63, fr = lane & 15, fq = lane >> 4;
    const bf16_t* qb = (const bf16_t*)(p.ws + WS_Z); const bf16_t* kb = (const bf16_t*)(p.ws + WS_Z + 1 * HSZ); const bf16_t* gb = (const bf16_t*)(p.ws + WS_Z + 2 * HSZ);
    const bf16_t* vt = (const bf16_t*)(p.ws + WS_Z + 5 * HSZ); const bf16_t* wb = (const bf16_t*)p.out + USZ / 2; bf16_t* mixed = (bf16_t*)(p.ws + WS_BUFA);
    LAS unsigned char* Kt = lds; LAS unsigned char* VT = lds + TILEB; LAS unsigned char* Rf = lds + 2 * TILEB; LAS unsigned char* Rb = lds + 3 * TILEB;
    const int NU = NCHUNK * 4; const int i = 16 * wid + fr;
    u32x4 RT[2][4], RS[2][4]; bf16x8 qf[4];
#define R3_LOADQ(uu) do { const size_t t0_ = (size_t)((uu) >> 2) * 128; const int h_ = (uu) & 3; \
        _Pragma("unroll") for (int ks = 0; ks < 4; ++ks) qf[ks] = *(const bf16x8*)(qb + (t0_ + (16 * (tv >> 6) + (tv & 15))) * 512 + h_ * 128 + 32 * ks + 8 * ((tv >> 4) & 3)); } while (0)
#define R3_LOAD(uu) do { const int cg_ = (uu) >> 2, h_ = (uu) & 3; const size_t t0_ = (size_t)cg_ * 128; \
        _Pragma("unroll") for (int it = 0; it < 4; ++it) { const int id = tv + 512 * it, r = id >> 4, c = id & 15; \
            RT[0][it] = *(const u32x4*)(kb + (t0_ + r) * 512 + h_ * 128 + 8 * c); \
            RT[1][it] = *(const u32x4*)(vt + (size_t)(h_ * 128 + r) * T_TOK + t0_ + 8 * c); } } while (0)
    int u = blockIdx.x; int tv = tid; asm volatile("" : "+v"(tv));
    if (u < NU) { R3_LOAD(u); R3_LOADQ(u); }
    for (; u < NU; u += gridDim.x) {
        asm volatile("" : "+v"(tv));
        const int cgi = u >> 2, h = u & 3; const size_t t0 = (size_t)cgi * 128;
        const float lf2 = p.lg[h] * 1.4426950408889634f, lb2 = p.lg[4 + h] * 1.4426950408889634f;
#pragma unroll
        for (int it = 0; it < 4; ++it) { const int id = tv + 512 * it, r = id >> 4, c = id & 15;
            *(LAS u32x4*)(Kt + r * TS + c * 16) = RT[0][it]; *(LAS u32x4*)(VT + r * TS + c * 16) = RT[1][it]; }
#pragma unroll
        for (int it = 0; it < 4; ++it) { const int id = tv + 512 * it, r = id >> 4, c = id & 15;
            RS[0][it] = *(const u32x4*)(wb + ((size_t)(0 * NCHUNK + cgi) * 4 + h) * 16384 + r * 128 + 8 * c);
            RS[1][it] = *(const u32x4*)(wb + ((size_t)(1 * NCHUNK + cgi) * 4 + h) * 16384 + r * 128 + 8 * c); }
        __syncthreads();
        const bool more = u + (int)gridDim.x < NU;
        f32x4 S[8];
#pragma unroll
        for (int ni = 0; ni < 8; ++ni) S[ni] = zero_acc();
        mm_ra<8, 4>(S, qf, Kt, TS, fr, fq);
#pragma unroll
        for (int ni = 0; ni < 8; ++ni)
#pragma unroll
            for (int jj = 0; jj < 4; ++jj) { const int dist = i - (16 * ni + 4 * fq + jj); const float f = dist >= 0 ? fast_exp2(lf2 * (float)dist) : fast_exp2(lb2 * (float)(-dist)); S[ni][jj] *= f; }
        __builtin_amdgcn_sched_barrier(0);
        __syncthreads();
#pragma unroll
        for (int ni = 0; ni < 8; ++ni) { u32x2 pk; pk.x = cvt_pk_bf16(S[ni][0], S[ni][1]); pk.y = cvt_pk_bf16(S[ni][2], S[ni][3]); *(LAS u32x2*)(Kt + i * TS + (16 * ni + 4 * fq) * 2) = pk; }
#pragma unroll
        for (int it = 0; it < 4; ++it) { const int id = tv + 512 * it, r = id >> 4, c = id & 15;
            *(LAS u32x4*)(Rf + r * TS + c * 16) = RS[0][it]; *(LAS u32x4*)(Rb + r * TS + c * 16) = RS[1][it]; }
        __syncthreads();
        if (more) R3_LOAD(u + (int)gridDim.x);
        f32x4 Y[8];
#pragma unroll
        for (int ni = 0; ni < 8; ++ni) Y[ni] = zero_acc();
        { bf16x8 sa[4]; ld_afrag_lds<4>(sa, Kt + 16 * wid * TS, TS, fr, fq); mm_ra<8, 4>(Y, sa, VT, TS, fr, fq); }
        __builtin_amdgcn_sched_barrier(0);
        { f32x4 P[8];
#pragma unroll
          for (int ni = 0; ni < 8; ++ni) P[ni] = zero_acc();
          mm_ra<8, 4>(P, qf, Rf, TS, fr, fq);
          const float a = fast_exp2(lf2 * (float)(i + 1));
#pragma unroll
          for (int ni = 0; ni < 8; ++ni) Y[ni] += P[ni] * a; }
        __builtin_amdgcn_sched_barrier(0);
        { f32x4 P[8];
#pragma unroll
          for (int ni = 0; ni < 8; ++ni) P[ni] = zero_acc();
          mm_ra<8, 4>(P, qf, Rb, TS, fr, fq);
          const float b = fast_exp2(lb2 * (float)(128 - i));
#pragma unroll
          for (int ni = 0; ni < 8; ++ni) Y[ni] += P[ni] * b; }
        __builtin_amdgcn_sched_barrier(0);
        asm volatile("" ::: "memory");
        if (more) R3_LOADQ(u + (int)gridDim.x);
        float sm = 0.f;
#pragma unroll
        for (int ni = 0; ni < 8; ++ni) sm += (Y[ni][0] + Y[ni][1]) + (Y[ni][2] + Y[ni][3]);
        sm += __shfl_xor(sm, 16); sm += __shfl_xor(sm, 32);
        const float mu = sm * (1.0f / 128.0f); float q2 = 0.f;
#pragma unroll
        for (int ni = 0; ni < 8; ++ni) { const f32x4 d = Y[ni] - mu; q2 += (d[0] * d[0] + d[1] * d[1]) + (d[2] * d[2] + d[3] * d[3]); }
        q2 += __shfl_xor(q2, 16); q2 += __shfl_xor(q2, 32);
        const float rs = 1.0f / sqrtf(q2 * (1.0f / 128.0f) + EPSF);
        const bf16_t* gp = gb + (t0 + i) * 512 + h * 128 + 4 * fq; const float* gw = p.gn_w + h * 128 + 4 * fq; bf16_t* op = mixed + (t0 + i) * 1024 + h * 128 + 4 * fq;
#pragma unroll
        for (int ni = 0; ni < 8; ++ni) { const u32x2 gg = *(const u32x2*)(gp + 16 * ni); const f32x4 w4 = *(const f32x4*)(gw + 16 * ni); const f32x4 y = (Y[ni] - mu) * rs * w4;
            u32x2 pk; pk.x = cvt_pk_bf16(y[0] * lo_bf(gg.x), y[1] * hi_bf(gg.x)); pk.y = cvt_pk_bf16(y[2] * lo_bf(gg.y), y[3] * hi_bf(gg.y)); *(u32x2*)(op + 16 * ni) = pk; }
        __syncthreads();
    }
#undef R3_LOAD
#undef R3_LOADQ
}
template <int MODE> __device__ __forceinline__ void phase_norm(const Params& p, const bf16_t* y, const bf16_t* xbin, const float* wa, bf16_t* xb, float* rsn) {
    const int wid = threadIdx.x >> 6, lane = threadIdx.x & 63; const int gw = blockIdx.x * 8 + wid, nw = gridDim.x * 8;
    constexpr int NR = 4;
    for (int r0 = NR * gw; r0 < T_TOK; r0 += NR * nw) {
        f32x4 yv[NR][4], xv[NR][4]; float ss[NR];
#pragma unroll
        for (int k = 0; k < NR; ++k) { const int r = r0 + k;
#pragma unroll
            for (int i = 0; i < 4; ++i) { const u32x2 w = *(const u32x2*)(y + (size_t)r * DM + lane * 4 + 256 * i); yv[k][i] = (f32x4){lo_bf(w.x), hi_bf(w.x), lo_bf(w.y), hi_bf(w.y)};
                if (MODE == 0) xv[k][i] = __builtin_nontemporal_load((const f32x4*)(xrow(p, r) + lane * 4 + 256 * i));
                else { const u32x2 xw = *(const u32x2*)(xbin + (size_t)r * DM + lane * 4 + 256 * i); xv[k][i] = (f32x4){lo_bf(xw.x), hi_bf(xw.x), lo_bf(xw.y), hi_bf(xw.y)}; } } }
#pragma unroll
        for (int k = 0; k < NR; ++k) { ss[k] = 0.f;
#pragma unroll
            for (int i = 0; i < 4; ++i) ss[k] += yv[k][i][0] * yv[k][i][0] + yv[k][i][1] * yv[k][i][1] + yv[k][i][2] * yv[k][i][2] + yv[k][i][3] * yv[k][i][3];
            ss[k] = wave_sum(ss[k]); }
#pragma unroll
        for (int k = 0; k < NR; ++k) { const int r = r0 + k; const float r1 = 1.0f / sqrtf(ss[k] * (1.0f / 1024.0f) + EPSF); float s2 = 0.f;
#pragma unroll
            for (int i = 0; i < 4; ++i) { const f32x4 wv = *(const f32x4*)(wa + lane * 4 + 256 * i); const f32x4 xo = xv[k][i] + yv[k][i] * r1 * wv;
                if (MODE == 2) __builtin_nontemporal_store(xo, (f32x4*)(p.out + (size_t)r * DM + lane * 4 + 256 * i));
                else { u32x2 pk; pk.x = cvt_pk_bf16(xo[0], xo[1]); pk.y = cvt_pk_bf16(xo[2], xo[3]); *(u32x2*)(xb + (size_t)r * DM + lane * 4 + 256 * i) = pk;
                       s2 += xo[0] * xo[0] + xo[1] * xo[1] + xo[2] * xo[2] + xo[3] * xo[3]; } }
            if (MODE != 2) { s2 = wave_sum(s2); if (lane == 0) rsn[r] = 1.0f / sqrtf(s2 * (1.0f / 1024.0f) + EPSF); } }
    }
}
__device__ __forceinline__ void phase_xattn(const Params& p, LAS unsigned char* lds) {
    int tid_l = threadIdx.x; asm volatile("" : "+v"(tid_l)); const int tid = tid_l, wid = tid >> 6, lane = tid & 63, fr = lane & 15, fq = lane >> 4;
    const bf16_t* qx = (const bf16_t*)(p.ws + WS_Z); const bf16_t* kx = (const bf16_t*)(p.ws + WS_KX); const bf16_t* vxt = (const bf16_t*)(p.ws + WS_VXT);
    bf16_t* ob = (bf16_t*)(p.ws + WS_BUFA);
    LAS unsigned char* RA = lds; LAS unsigned char* RP = lds + 2 * TILEB;
    const int NU = NCHUNK * 4; const int i = 16 * wid + fr;
    u32x4 R[8]; bf16x8 qf[8], qn[8];
#define XA_M0(uu) ((size_t)((((uu) >> 2) * 128 < T_PROMPT) ? ((((uu) >> 2) * 128) >> 12) : 16 + (((((uu) >> 2) * 128) - T_PROMPT) >> 13)) * 256)
#define XA_LOADK(uu, dh) do { const size_t m0_ = XA_M0(uu); const int h_ = (uu) & 3; \
        _Pragma("unroll") for (int it = 0; it < 8; ++it) { const int id = tid + 512 * it, r = id >> 4, c = id & 15; R[it] = *(const u32x4*)(kx + (m0_ + r) * 1024 + h_ * 256 + (dh) * 128 + 8 * c); } } while (0)
#define XA_LOADV(uu, dh) do { const size_t m0_ = XA_M0(uu); const int h_ = (uu) & 3; \
        _Pragma("unroll") for (int it = 0; it < 8; ++it) { const int id = tid + 512 * it, r = id >> 5, c = id & 31; R[it] = *(const u32x4*)(vxt + (size_t)(h_ * 256 + (dh) * 128 + r) * NMEMROWS + m0_ + 8 * c); } } while (0)
#define XA_STOREK() do { _Pragma("unroll") for (int it = 0; it < 8; ++it) { const int id = tid + 512 * it, r = id >> 4, c = id & 15; *(LAS u32x4*)(RA + r * TS + c * 16) = R[it]; } } while (0)
#define XA_STOREV() do { _Pragma("unroll") for (int it = 0; it < 8; ++it) { const int id = tid + 512 * it, r = id >> 5, c = id & 31; *(LAS u32x4*)(RA + r * TS2 + c * 16) = R[it]; } } while (0)
#define XA_LOADQ(uu, QD) do { const size_t t0_ = (size_t)((uu) >> 2) * 128; const int h_ = (uu) & 3; \
        _Pragma("unroll") for (int ks = 0; ks < 8; ++ks) QD[ks] = *(const bf16x8*)(qx + (t0_ + i) * 1024 + h_ * 256 + 32 * ks + 8 * fq); } while (0)
    int u = blockIdx.x;
    if (u < NU) { XA_LOADK(u, 0); XA_LOADQ(u, qf); }
    for (; u < NU; u += gridDim.x) {
        const int h = u & 3; const size_t t0 = (size_t)(u >> 2) * 128;
        f32x4 S[16];
#pragma unroll
        for (int ni = 0; ni < 16; ++ni) S[ni] = zero_acc();
        XA_STOREK(); __syncthreads(); XA_LOADK(u, 1);
        { bf16x8 a4[4];
#pragma unroll
          for (int ks = 0; ks < 4; ++ks) a4[ks] = qf[ks];
          mm_ra<16, 4>(S, a4, RA, TS, fr, fq); }
        __syncthreads();
        XA_STOREK(); __syncthreads(); XA_LOADV(u, 0);
        { bf16x8 a4[4];
#pragma unroll
          for (int ks = 0; ks < 4; ++ks) a4[ks] = qf[4 + ks];
          mm_ra<16, 4>(S, a4, RA, TS, fr, fq); }
        float mx = -3.0e38f;
#pragma unroll
        for (int ni = 0; ni < 16; ++ni) mx = fmaxf(mx, fmaxf(fmaxf(S[ni][0], S[ni][1]), fmaxf(S[ni][2], S[ni][3])));
        mx = fmaxf(mx, __shfl_xor(mx, 16)); mx = fmaxf(mx, __shfl_xor(mx, 32));
        float sum = 0.f;
#pragma unroll
        for (int ni = 0; ni < 16; ++ni) {
#pragma unroll
            for (int j = 0; j < 4; ++j) { const float e = fast_exp2((S[ni][j] - mx) * 1.4426950408889634f); S[ni][j] = e; sum += e; }
            u32x2 pk; pk.x = cvt_pk_bf16(S[ni][0], S[ni][1]); pk.y = cvt_pk_bf16(S[ni][2], S[ni][3]); *(LAS u32x2*)(RP + i * TS2 + (16 * ni + 4 * fq) * 2) = pk; }
        sum += __shfl_xor(sum, 16); sum += __shfl_xor(sum, 32);
        const float rinv = 1.0f / sum;
        __syncthreads();
        XA_STOREV(); __syncthreads(); XA_LOADV(u, 1);
        bf16x8 pa[8]; ld_afrag_lds<8>(pa, RP + 16 * wid * TS2, TS2, fr, fq);
        { f32x4 O[8];
#pragma unroll
          for (int ni = 0; ni < 8; ++ni) O[ni] = zero_acc();
          mm_ra<8, 8>(O, pa, RA, TS2, fr, fq);
          bf16_t* op = ob + (t0 + i) * 1024 + h * 256 + 4 * fq;
#pragma unroll
          for (int ni = 0; ni < 8; ++ni) { const f32x4 o = O[ni] * rinv; u32x2 pk; pk.x = cvt_pk_bf16(o[0], o[1]); pk.y = cvt_pk_bf16(o[2], o[3]); *(u32x2*)(op + 16 * ni) = pk; } }
        __syncthreads();
        XA_STOREV(); __syncthreads();
        const bool more = u + (int)gridDim.x < NU;
        if (more) { XA_LOADK(u + (int)gridDim.x, 0); XA_LOADQ(u + (int)gridDim.x, qn); }
        { f32x4 O[8];
#pragma unroll
          for (int ni = 0; ni < 8; ++ni) O[ni] = zero_acc();
          mm_ra<8, 8>(O, pa, RA, TS2, fr, fq);
          bf16_t* op = ob + (t0 + i) * 1024 + h * 256 + 128 + 4 * fq;
#pragma unroll
          for (int ni = 0; ni < 8; ++ni) { const f32x4 o = O[ni] * rinv; u32x2 pk; pk.x = cvt_pk_bf16(o[0], o[1]); pk.y = cvt_pk_bf16(o[2], o[3]); *(u32x2*)(op + 16 * ni) = pk; } }
        __syncthreads();
        if (more) {
#pragma unroll
            for (int ks = 0; ks < 8; ++ks) qf[ks] = qn[ks];
        }
    }
#undef XA_M0
#undef XA_LOADK
#undef XA_LOADV
#undef XA_STOREK
#undef XA_STOREV
#undef XA_LOADQ
}

#define XB_TMO      128
#define XB_XCNT(j)  (256  + 64 * (j))
#define XB_XSUB(j)  (1280 + 64 * (j))
#define XB_XGEN(j)  (2304 + 64 * (j))
#define XB_TOP      3328
#define XB_TOPGEN   3392
#define XCD_BAR_WORDS 3456
#define XB_SPIN_CAP (1u << 18)
__device__ __forceinline__ unsigned xb_ld(unsigned* p)              { return __hip_atomic_load(p, __ATOMIC_RELAXED, __HIP_MEMORY_SCOPE_AGENT); }
__device__ __forceinline__ unsigned xb_add(unsigned* p, unsigned v) { return __hip_atomic_fetch_add(p, v, __ATOMIC_RELAXED, __HIP_MEMORY_SCOPE_AGENT); }
__device__ __forceinline__ unsigned xb_xcc_id() { return (unsigned)__builtin_amdgcn_s_getreg((3 << 11) | 20) & 0xFu; }
#define XB_SPIN(cond, bar) do { unsigned _sp = 0; while (cond) { __builtin_amdgcn_s_sleep(1); \
    if ((++_sp & 255u) == 0u) { if (xb_ld(&(bar)[XB_TMO])) break; if (_sp > XB_SPIN_CAP) { atomicAdd(&(bar)[XB_TMO], 1u); break; } } } } while (0)
struct XcdBarrier { unsigned* bar; unsigned x; volatile LAS unsigned* st; };
__device__ __forceinline__ XcdBarrier xcd_barrier_post(unsigned* bar, volatile LAS unsigned* st) {
    XcdBarrier b; b.bar = bar; b.x = xb_xcc_id(); b.st = st;
    if (threadIdx.x == 0) (void)xb_add(&bar[XB_XCNT(b.x)], 1u);
    return b;
}
__device__ __forceinline__ void xcd_barrier_complete(unsigned* bar, unsigned x, unsigned& nloc, unsigned& nx) {
    const unsigned G = gridDim.x * gridDim.y * gridDim.z;
    unsigned sum, cnt, mine, sp = 0u;
    for (;;) {
        sum = 0u; cnt = 0u; mine = 0u;
#pragma unroll
        for (unsigned j = 0; j < 16; ++j) { const unsigned c = xb_ld(&bar[XB_XCNT(j)]); sum += c; cnt += (c > 0u) ? 1u : 0u; mine = (j == x) ? c : mine; }
        if (sum == G) break;
        __builtin_amdgcn_s_sleep(1);
        if ((++sp & 255u) == 0u) { if (xb_ld(&bar[XB_TMO])) break; if (sp > XB_SPIN_CAP) { atomicAdd(&bar[XB_TMO], 1u); break; } }
    }
    nloc = mine > 0u ? mine : 1u; nx = cnt > 0u ? cnt : 1u;
}
__device__ __forceinline__ void xcd_barrier(const XcdBarrier& b) {
    asm volatile("s_waitcnt vmcnt(0)" ::: "memory");
    __syncthreads();
    if (threadIdx.x == 0) {
        unsigned* bar = b.bar;
        __builtin_amdgcn_s_waitcnt(0);
        unsigned nloc = b.st[0], nx = b.st[1];
        if (nloc == 0u) { xcd_barrier_complete(bar, b.x, nloc, nx); b.st[0] = nloc; b.st[1] = nx; }
        const unsigned old = xb_add(&bar[XB_XSUB(b.x)], 1u);
        const unsigned gen = old / nloc;
        if (old + 1u == (gen + 1u) * nloc) {
            __builtin_amdgcn_fence(__ATOMIC_RELEASE, "agent");
            asm volatile("s_waitcnt vmcnt(0)" ::: "memory");
            const unsigned og = xb_add(&bar[XB_TOP], 1u);
            const unsigned tg = og / nx;
            if (og + 1u == (tg + 1u) * nx) xb_add(&bar[XB_TOPGEN], 1u);
            else XB_SPIN(xb_ld(&bar[XB_TOPGEN]) == tg, bar);
            __builtin_amdgcn_fence(__ATOMIC_ACQUIRE, "agent");
            xb_add(&bar[XB_XGEN(b.x)], 1u);
            asm volatile("s_waitcnt vmcnt(0)" ::: "memory");
        } else {
            XB_SPIN(xb_ld(&bar[XB_XGEN(b.x)]) == gen, bar);
            __builtin_amdgcn_fence(__ATOMIC_ACQUIRE, "agent");
            asm volatile("s_waitcnt vmcnt(0)" ::: "memory");
        }
    }
    __syncthreads();
}
#ifdef PG8_V2
#ifndef PG8_ALIGN
#define PG8_ALIGN true
#endif
#ifndef PG8_SP2
#define PG8_SP2 true
#endif
#define GEMM_PHASE(EPI, g, S, E) pg8::gemm_phase<EPI, pg8::StaticOrder, PG8_ALIGN, PG8_SP2>(lds, g, S, E)
#else
#define GEMM_PHASE(EPI, g, S, E) pg8::gemm_phase<EPI, pg8::StaticOrder>(lds, g, S, E, nullptr)
#endif
enum { PH_PREP = 0, PH_G1A, PH_G1B, PH_GK, PH_GV, PH_MIX, PH_R1, PH_SCAN, PH_R3, PH_GOUT, PH_N1, PH_GQ, PH_XA, PH_GO, PH_N2, PH_GGU, PH_GDN, PH_N3, PH_COUNT };

__global__ void __launch_bounds__(512) fwd_megakernel(Params p) {
    extern __shared__ __attribute__((aligned(16))) unsigned char lds_raw[];
    LAS unsigned char* lds = (LAS unsigned char*)lds_raw;
    cg::grid_group grid = cg::this_grid();
    unsigned char* ws = p.ws;
    bf16_t* bufa = (bf16_t*)(ws + WS_BUFA); bf16_t* zb = (bf16_t*)(ws + WS_Z); bf16_t* z1 = (bf16_t*)(ws + WS_Z + USZ);
    const int G = gridDim.x, c = blockIdx.x;
    volatile LAS unsigned* xbst = (volatile LAS unsigned*)(lds + XBST_OFF);
    if (threadIdx.x == 0) { xbst[0] = 0u; xbst[1] = 0u; }
    __syncthreads();
    XcdBarrier xbar; xbar.bar = (unsigned*)(ws + WS_BAR); xbar.x = 0; xbar.st = xbst;
    if (p.hi - p.lo > 1) xbar = xcd_barrier_post((unsigned*)(ws + WS_BAR), xbst);
#define IN(k) (p.lo <= (k) && (k) < p.hi)
#define GSYNC() xcd_barrier(xbar)
#define SEAM(k) do { __syncthreads(); if (IN((k) + 1)) GSYNC(); } while (0)
#define PLAINRS(gg, ee) do { const pg8::Gemm g_ = gg; const EpiPlainRS e_ = ee; pg8::StaticOrder S_; S_.init(g_.M, g_.N, G, c); GEMM_PHASE(EpiPlainRS, g_, S_, e_); } while (0)
#define PLAIN(gg, ee) do { const pg8::Gemm g_ = gg; const EpiPlain e_ = ee; pg8::StaticOrder S_; S_.init(g_.M, g_.N, G, c); GEMM_PHASE(EpiPlain, g_, S_, e_); } while (0)
#define ON(k) (!defined(ONLY_PH) || (ONLY_PH == (k)))
#ifndef DUP_MASK
#define DUP_MASK 0
#endif
#define REPS(k) for (int rep_ = 0; rep_ < 1 + ((DUP_MASK >> (k)) & 1); ++rep_)
#if ON(0)
    if (IN(PH_PREP)) { REPS(PH_PREP) { phase_prep(p, lds); } if (IN(PH_PREP + 1)) { asm volatile("s_waitcnt vmcnt(0)" ::: "memory"); __syncthreads(); grid.sync();
            __builtin_amdgcn_fence(__ATOMIC_ACQUIRE, "agent"); asm volatile("s_waitcnt vmcnt(0)" ::: "memory"); __syncthreads(); } }
#endif
#if ON(1)
    if (IN(PH_G1A)) { pg8::Gemm g1{bufa, (const bf16_t*)(ws + WS_WIN), T_TOK, 2560, 1024}; pg8::StaticOrder S; S.init(T_TOK, 2560, G, c);
        EpiG1A E{zb, (const float*)(ws + WS_COS), (const float*)(ws + WS_SIN)};
        REPS(PH_G1A) { GEMM_PHASE(EpiG1A, g1, S, E); __syncthreads(); } }
#endif
#if ON(2)
    for (int s = PH_G1B; s <= PH_GK; ++s) if (IN(s)) {
        pg8::Gemm g; EpiPlain e; int cc = c;
        if (s == PH_G1B) { g = pg8::Gemm{(const bf16_t*)(ws + WS_WINV), bufa, 512, T_TOK, 1024}; e = EpiPlain{(bf16_t*)(ws + WS_Z + 5 * HSZ), (size_t)T_TOK, 1.0f}; }
        else if (c < 80 || c >= 160) { g = pg8::Gemm{(const bf16_t*)(ws + WS_MEMN), (const bf16_t*)(ws + WS_WKV), NMEMROWS, 1024, 1024}; e = EpiPlain{(bf16_t*)(ws + WS_KX), 1024, 1.0f}; }
        else { g = pg8::Gemm{(const bf16_t*)(ws + WS_WKV) + (size_t)1024 * 1024, (const bf16_t*)(ws + WS_MEMN), 1024, NMEMROWS, 1024}; e = EpiPlain{(bf16_t*)(ws + WS_VXT), (size_t)NMEMROWS, 1.0f}; cc = c - 80; }
        { const pg8::Gemm g_ = g; const EpiPlain e_ = e; pg8::StaticOrder S_; S_.init(g_.M, g_.N, G, cc); GEMM_PHASE(EpiPlain, g_, S_, e_); } __syncthreads();
        if (s == PH_GK && IN(PH_GK + 1)) GSYNC();
    }
#endif
#if ON(5)
    if (IN(PH_MIX)) { REPS(PH_MIX) { phase_sgu(p, lds); } }
    if (IN(PH_R1)) { REPS(PH_R1) { phase_r1(p, lds); } SEAM(PH_R1); }
#endif
#if ON(6)
    if (IN(PH_SCAN)) { phase_scan(p); SEAM(PH_SCAN); }
#endif
#if ON(7)
    if (IN(PH_R3)) { REPS(PH_R3) { phase_r3(p, lds); } SEAM(PH_R3); }
#endif
#if ON(8)
    if (IN(PH_GOUT)) { REPS(PH_GOUT) PLAIN((pg8::Gemm{bufa, (const bf16_t*)(ws + WS_WOUT), T_TOK, 1024, 1024}), (EpiPlain{zb, 1024, 1.0f})); SEAM(PH_GOUT); }
#endif
#if ON(9)
    if (IN(PH_N1)) { REPS(PH_N1) { phase_norm<0>(p, zb, nullptr, p.norm_w + 1 * DM, z1, (float*)(ws + WS_RS2)); } SEAM(PH_N1); }
#endif
#if ON(10)
    if (IN(PH_GQ)) { REPS(PH_GQ) PLAINRS((pg8::Gemm{z1, (const bf16_t*)(ws + WS_WQ), T_TOK, 1024, 1024}), (EpiPlainRS{zb, 1024, 0.0625f, (const float*)(ws + WS_RS2)})); SEAM(PH_GQ); }
#endif
#if ON(11)
    if (IN(PH_XA)) { REPS(PH_XA) { phase_xattn(p, lds); } SEAM(PH_XA); }
#endif
#if ON(12)
    if (IN(PH_GO)) { REPS(PH_GO) PLAIN((pg8::Gemm{bufa, (const bf16_t*)(ws + WS_WO), T_TOK, 1024, 1024}), (EpiPlain{zb, 1024, 1.0f})); SEAM(PH_GO); }
#endif
#if ON(13)
    if (IN(PH_N2)) { phase_norm<1>(p, zb, z1, p.norm_w + 3 * DM, bufa, (float*)(ws + WS_RS5)); SEAM(PH_N2); }
#endif
#if ON(14)
    if (IN(PH_GGU)) { pg8::Gemm g5{bufa, (const bf16_t*)(ws + WS_WGU), T_TOK, 2 * DFF, 1024}; pg8::StaticOrder S; S.init(T_TOK, 2 * DFF, G, c);
        EpiGU E{zb, (const float*)(ws + WS_RS5)}; REPS(PH_GGU) { GEMM_PHASE(EpiGU, g5, S, E); __syncthreads(); } SEAM(PH_GGU); }
#endif
#if ON(15)
    if (IN(PH_GDN)) { REPS(PH_GDN) PLAIN((pg8::Gemm{zb, (const bf16_t*)(ws + WS_WDN), T_TOK, 1024, DFF}), (EpiPlain{(bf16_t*)(ws + WS_FF), 1024, 1.0f})); SEAM(PH_GDN); }
#endif
#if ON(16)
    if (IN(PH_N3)) { phase_norm<2>(p, (const bf16_t*)(ws + WS_FF), bufa, p.norm_w + 6 * DM, nullptr, nullptr); }
#endif
#ifdef CUT
    if (p.lo == 100) {
        const size_t gt = (size_t)blockIdx.x * 512 + threadIdx.x, gs = (size_t)gridDim.x * 512, NO = (size_t)T_TOK * 1024;
        for (size_t i = gt; i < NO; i += gs) { float v = 0.f;
            if (CUT == 4) { const bf16_t* z = zb; v = lo_bf(z[3 * i]) + 2.f * lo_bf(z[3 * i + 1]) + 3.f * lo_bf(z[3 * i + 2]);
                if (i < (size_t)NMEMROWS * 1024) v += lo_bf(((const bf16_t*)(ws + WS_KX))[i]) + 5.f * lo_bf(((const bf16_t*)(ws + WS_VXT))[i]); }
            else if (CUT == 5 || CUT == 6) {
#if defined(DIG_A)
                v = lo_bf(((const bf16_t*)(ws + WS_Z + 3 * HSZ))[i]);
#elif defined(DIG_B)
                v = ((i & 1023) >= 512) ? lo_bf(bufa[i]) : 0.f;
#else
                v = lo_bf(bufa[i]) * (float)((i & 1023) >= 512) + lo_bf(((const bf16_t*)p.out)[i]);
#endif
            }
            else if (CUT == 6) { v = lo_bf(((const bf16_t*)p.out)[i]); }
            else v = lo_bf(bufa[i]);
            p.out[i] = v; }
    }
    if (false) {
        const size_t gt = (size_t)blockIdx.x * 512 + threadIdx.x, gs = (size_t)gridDim.x * 512, NO = (size_t)T_TOK * 1024;
        for (size_t i = gt; i < NO; i += gs) p.out[i] = ((const float*)(ws + WS_Z))[i];
    }
#endif
}

extern "C" void kernel_launch(void* const* d_in, const int* in_sizes, int n_in, void* d_out, int out_size, void* d_ws, size_t ws_size, hipStream_t stream) {
    static int grid_blocks = 0;
    if (!grid_blocks) {
        int dev = 0, cus = 0, per_cu = 0;
        hipGetDevice(&dev);
        hipDeviceGetAttribute(&cus, hipDeviceAttributeMultiprocessorCount, dev);
        hipFuncSetAttribute((const void*)fwd_megakernel, hipFuncAttributeMaxDynamicSharedMemorySize, LDS_BYTES);
        hipOccupancyMaxActiveBlocksPerMultiprocessor(&per_cu, (const void*)fwd_megakernel, 512, LDS_BYTES);
        if (per_cu < 1) { fprintf(stderr, "occupancy query says %d blocks/CU\n", per_cu); per_cu = 1; }
        (void)hipGetLastError();
        grid_blocks = cus;
        if (ws_size < WS_END) fprintf(stderr, "workspace too small: %zu < %zu\n", ws_size, (size_t)WS_END);
    }
    if (ws_size < WS_END) return;
    Params p{};
    p.x_p = (const float*)d_in[0]; p.x_s = (const float*)d_in[1]; p.mem_p = (const float*)d_in[2]; p.mem_s = (const float*)d_in[3]; p.norm_w = (const float*)d_in[4];
    p.w_in = (const float*)d_in[5]; p.lg = (const float*)d_in[6]; p.gn_w = (const float*)d_in[7]; p.sgu_nw = (const float*)d_in[8]; p.sgu_w = (const float*)d_in[9];
    p.sgu_b = (const float*)d_in[10]; p.w_out = (const float*)d_in[11]; p.wq = (const float*)d_in[12]; p.wkv = (const float*)d_in[13]; p.wo = (const float*)d_in[14];
    p.wgu = (const float*)d_in[15]; p.wdn = (const float*)d_in[16];
    p.out = (float*)d_out; p.ws = (unsigned char*)d_ws;
#ifndef N_SPLIT
#define N_SPLIT 0
#endif
    if (N_SPLIT) {
#ifdef CUT
        const int nph = CUT + 1, nextra = 2;
#else
        const int nph = PH_COUNT, nextra = 0;
#endif
        for (int ph = 0; ph < nph + nextra; ++ph) { if (ph >= nph) { p.lo = 100 + (ph - nph); p.hi = p.lo; } else { p.lo = ph; p.hi = ph + 1; }
            void* args[] = {&p};
            hipError_t e = hipLaunchCooperativeKernel((const void*)fwd_megakernel, dim3(grid_blocks), dim3(512), args, LDS_BYTES, stream);
            if (e != hipSuccess) fprintf(stderr, "cooperative launch failed: %s (grid %d)\n", hipGetErrorString(e), grid_blocks); }
        return;
    }
    (void)hipMemsetAsync((unsigned char*)d_ws + WS_BAR, 0, XCD_BAR_WORDS * 4, stream);
    p.lo = 0; p.hi = PH_COUNT;
    void* args[] = {&p};
    hipError_t e = hipLaunchCooperativeKernel((const void*)fwd_megakernel, dim3(grid_blocks), dim3(512), args, LDS_BYTES, stream);
    if (e != hipSuccess) fprintf(stderr, "cooperative launch failed: %s (grid %d)\n", hipGetErrorString(e), grid_blocks);
}
```
